# Optimizing an MI355X kernel written in HIP

```python
import math
import jax, jax.numpy as jnp
from jax import lax
import numpy as np

D_MODEL = 1024
BATCH = 32
SEQ = 2048
DEPTH = 2
DEC_BATCH = 16
DEC_SEQ = 2048
PAST_LEN = 128

GRID_W = 64
HEAD_DIM = 64
A_HEADS = D_MODEL // 256
A_V_DIM = 2 * HEAD_DIM
A_WIDTH = A_HEADS * A_V_DIM
B_HEADS = D_MODEL // 128
B_WIDTH = B_HEADS * HEAD_DIM
AB_IN = 3 * A_WIDTH + 3 * B_WIDTH
C_HEADS = D_MODEL // HEAD_DIM
C_KV_HEADS = C_HEADS // 4
C_GROUP = C_HEADS // C_KV_HEADS
C_IN = (C_HEADS + 2 * C_KV_HEADS) * HEAD_DIM
ROPE_AXIS_DIM = HEAD_DIM // 2
ROPE_THETA = 10000.0
NA_ROWS_MAX = 8
NA_COLS = 16
Q_BLOCK = 128
D_FF = 2816
NORM_EPS = 1e-6
N_EVEN = (DEPTH + 1) // 2
N_ODD = DEPTH // 2

kernel_name = 'hybrid_diff_na_axial_gqa_macaron_encoder'


def rms_norm(x, gain):
    xf = x.astype(jnp.float32)
    y = xf * lax.rsqrt(jnp.mean(xf * xf, axis=-1, keepdims=True) + NORM_EPS)
    return (y * gain.astype(jnp.float32)).astype(x.dtype)


def swiglu(x, w_gate, w_up, w_down):
    return (jax.nn.silu(x @ w_gate) * (x @ w_up)) @ w_down


def alibi_slopes(n_heads):
    return jnp.asarray(2.0 ** (-8.0 * np.arange(1, n_heads + 1) / n_heads), dtype=jnp.float32)


def diff_attention(q, k, v, lam):
    bsz, seq = q.shape[0], q.shape[1]
    nb = seq // Q_BLOCK
    scale = HEAD_DIM ** -0.5
    slopes = alibi_slopes(A_HEADS)
    key_pos = jnp.arange(seq)
    qb = jnp.moveaxis(q.reshape(bsz, nb, Q_BLOCK, A_HEADS, 2, HEAD_DIM), 1, 0)

    def one_block(args):
        q_blk, start = args
        s = jnp.einsum('bqhcd,bkhcd->cbhqk', q_blk, k, preferred_element_type=jnp.float32) * scale
        q_pos = start + jnp.arange(Q_BLOCK)
        dist = jnp.abs(q_pos[:, None] - key_pos[None, :]).astype(jnp.float32)
        s = s - slopes[:, None, None] * dist
        p = jax.nn.softmax(s, axis=-1)
        attn = p[0] - lam * p[1]
        return jnp.einsum('bhqk,bkhe->bqhe', attn.astype(v.dtype), v)

    starts = jnp.arange(nb) * Q_BLOCK
    out = lax.map(one_block, (qb, starts))
    return jnp.moveaxis(out, 0, 1).reshape(bsz, seq, A_HEADS, A_V_DIM)


def neighbourhood_attention(q, k, v, rpb):
    bsz, seq, n_heads, dh = q.shape
    rows = seq // GRID_W
    wr = min(NA_ROWS_MAX, rows)
    scale = dh ** -0.5
    qg = jnp.moveaxis(q.reshape(bsz, rows, GRID_W, n_heads, dh), 1, 0)
    kg = k.reshape(bsz, rows, GRID_W, n_heads, dh)
    vg = v.reshape(bsz, rows, GRID_W, n_heads, dh)
    r = jnp.arange(rows)
    row_idx = jnp.clip(r - wr // 2, 0, rows - wr)[:, None] + jnp.arange(wr)[None, :]
    c = jnp.arange(GRID_W)
    col_idx = jnp.clip(c - NA_COLS // 2, 0, GRID_W - NA_COLS)[:, None] + jnp.arange(NA_COLS)[None, :]
    dc_idx = col_idx - c[:, None] + (NA_COLS - 1)

    def one_row(args):
        q_row, rid, r0 = args
        k_nb = kg[:, rid][:, :, col_idx]
        v_nb = vg[:, rid][:, :, col_idx]
        s = jnp.einsum('bchd,brcwhd->bhcrw', q_row, k_nb, preferred_element_type=jnp.float32) * scale
        dr_idx = rid - r0 + (NA_ROWS_MAX - 1)
        bias = rpb[:, dr_idx][:, :, dc_idx]
        s = s + jnp.transpose(bias, (0, 2, 1, 3)).astype(jnp.float32)[None]
        p = jax.nn.softmax(s.reshape(bsz, n_heads, GRID_W, wr * NA_COLS), axis=-1).reshape(s.shape)
        return jnp.einsum('bhcrw,brcwhd->bchd', p.astype(v.dtype), v_nb)

    out = lax.map(one_row, (qg, row_idx, r))
    return jnp.moveaxis(out, 0, 1).reshape(bsz, seq, n_heads, dh)


def mixer_ab(h, w_in, w_out, a_q_norm, a_k_norm, a_lambda_q1, a_lambda_k1, a_lambda_q2, a_lambda_k2,
             a_sub_norm, b_q_norm, b_k_norm, b_rpb, lambda_init):
    bsz, seq, _ = h.shape
    proj = h @ w_in
    aq, ak, av, bq, bk, bv = jnp.split(
        proj, [A_WIDTH, 2 * A_WIDTH, 3 * A_WIDTH, 3 * A_WIDTH + B_WIDTH, 3 * A_WIDTH + 2 * B_WIDTH], axis=-1)
    aq = rms_norm(aq.reshape(bsz, seq, A_HEADS, 2, HEAD_DIM), a_q_norm)
    ak = rms_norm(ak.reshape(bsz, seq, A_HEADS, 2, HEAD_DIM), a_k_norm)
    av = av.reshape(bsz, seq, A_HEADS, A_V_DIM)
    lam = (jnp.exp(jnp.sum(a_lambda_q1.astype(jnp.float32) * a_lambda_k1.astype(jnp.float32)))
           - jnp.exp(jnp.sum(a_lambda_q2.astype(jnp.float32) * a_lambda_k2.astype(jnp.float32)))
           + lambda_init)
    a_out = diff_attention(aq, ak, av, lam)
    a_out = rms_norm(a_out, a_sub_norm) * (1.0 - lambda_init)
    bq = rms_norm(bq.reshape(bsz, seq, B_HEADS, HEAD_DIM), b_q_norm)
    bk = rms_norm(bk.reshape(bsz, seq, B_HEADS, HEAD_DIM), b_k_norm)
    bv = bv.reshape(bsz, seq, B_HEADS, HEAD_DIM)
    b_out = neighbourhood_attention(bq, bk, bv, b_rpb)
    merged = jnp.concatenate([a_out.reshape(bsz, seq, A_WIDTH), b_out.reshape(bsz, seq, B_WIDTH)], axis=-1)
    return merged @ w_out


def axial_rope_angles(seq_len):
    t = jnp.arange(seq_len)
    inv_freq = ROPE_THETA ** (-jnp.arange(0, ROPE_AXIS_DIM, 2, dtype=jnp.float32) / ROPE_AXIS_DIM)
    ang_row = (t // GRID_W).astype(jnp.float32)[:, None] * inv_freq[None, :]
    ang_col = (t % GRID_W).astype(jnp.float32)[:, None] * inv_freq[None, :]
    return ang_row, ang_col


def rotate(x, ang):
    xf = x.astype(jnp.float32)
    half = xf.shape[-1] // 2
    x1, x2 = xf[..., :half], xf[..., half:]
    cos = jnp.cos(ang)[None, :, None, :]
    sin = jnp.sin(ang)[None, :, None, :]
    return jnp.concatenate([x1 * cos - x2 * sin, x2 * cos + x1 * sin], axis=-1).astype(x.dtype)


def apply_axial_rope(x, ang_row, ang_col):
    return jnp.concatenate([rotate(x[..., :ROPE_AXIS_DIM], ang_row),
                            rotate(x[..., ROPE_AXIS_DIM:], ang_col)], axis=-1)


def gqa_attention(q, k, v):
    bsz, seq = q.shape[0], q.shape[1]
    nb = seq // Q_BLOCK
    scale = HEAD_DIM ** -0.5
    qb = jnp.moveaxis(q.reshape(bsz, nb, Q_BLOCK, C_KV_HEADS, C_GROUP, HEAD_DIM), 1, 0)

    def one_block(q_blk):
        s = jnp.einsum('bqkgd,bskd->bkgqs', q_blk, k, preferred_element_type=jnp.float32) * scale
        p = jax.nn.softmax(s, axis=-1)
        return jnp.einsum('bkgqs,bskd->bqkgd', p.astype(v.dtype), v)

    out = lax.map(one_block, qb)
    return jnp.moveaxis(out, 0, 1).reshape(bsz, seq, C_HEADS * HEAD_DIM)


def mixer_c(h, w_in, w_out, q_norm, k_norm):
    bsz, seq, _ = h.shape
    proj = h @ w_in
    q, k, v = jnp.split(proj, [C_HEADS * HEAD_DIM, (C_HEADS + C_KV_HEADS) * HEAD_DIM], axis=-1)
    q = rms_norm(q.reshape(bsz, seq, C_HEADS, HEAD_DIM), q_norm)
    k = rms_norm(k.reshape(bsz, seq, C_KV_HEADS, HEAD_DIM), k_norm)
    v = v.reshape(bsz, seq, C_KV_HEADS, HEAD_DIM)
    ang_row, ang_col = axial_rope_angles(seq)
    q = apply_axial_rope(q, ang_row, ang_col)
    k = apply_axial_rope(k, ang_row, ang_col)
    return gqa_attention(q, k, v) @ w_out


def trunk(x, ffn1_norm, ffn1_w_gate, ffn1_w_up, ffn1_w_down, mix_norm,
          ab_w_in, ab_w_out, a_q_norm, a_k_norm, a_lambda_q1, a_lambda_k1, a_lambda_q2, a_lambda_k2,
          a_sub_norm, b_q_norm, b_k_norm, b_rpb, c_w_in, c_w_out, c_q_norm, c_k_norm,
          ffn2_norm, ffn2_w_gate, ffn2_w_up, ffn2_w_down, final_norm):
    for layer in range(DEPTH):
        x = x + 0.5 * swiglu(rms_norm(x, ffn1_norm[layer]), ffn1_w_gate[layer], ffn1_w_up[layer], ffn1_w_down[layer])
        h = rms_norm(x, mix_norm[layer])
        i = layer // 2
        if layer % 2 == 0:
            lambda_init = 0.8 - 0.6 * math.exp(-0.3 * layer)
            x = x + mixer_ab(h, ab_w_in[i], ab_w_out[i], a_q_norm[i], a_k_norm[i],
                             a_lambda_q1[i], a_lambda_k1[i], a_lambda_q2[i], a_lambda_k2[i],
                             a_sub_norm[i], b_q_norm[i], b_k_norm[i], b_rpb[i], lambda_init)
        else:
            x = x + mixer_c(h, c_w_in[i], c_w_out[i], c_q_norm[i], c_k_norm[i])
        x = x + 0.5 * swiglu(rms_norm(x, ffn2_norm[layer]), ffn2_w_gate[layer], ffn2_w_up[layer], ffn2_w_down[layer])
        x = rms_norm(x, final_norm[layer])
    return x


def setup_inputs(seed: int = 0) -> dict:
    key = jax.random.key(seed)
    keys = jax.random.split(key, 32)

    def nrm(i, shape, scale):
        return scale * jax.random.normal(keys[i], shape, jnp.float32)

    def gain(i, shape):
        return 1.0 + 0.02 * jax.random.normal(keys[i], shape, jnp.float32)

    return {
        'x_prompt': nrm(0, (BATCH, SEQ, D_MODEL), 1.0),
        'x_sample': nrm(1, (DEC_BATCH, DEC_SEQ, D_MODEL), 1.0),
        'ffn1_norm': gain(2, (DEPTH, D_MODEL)),
        'ffn1_w_gate': nrm(3, (DEPTH, D_MODEL, D_FF), D_MODEL ** -0.5),
        'ffn1_w_up': nrm(4, (DEPTH, D_MODEL, D_FF), D_MODEL ** -0.5),
        'ffn1_w_down': nrm(5, (DEPTH, D_FF, D_MODEL), D_FF ** -0.5),
        'mix_norm': gain(6, (DEPTH, D_MODEL)),
        'ab_w_in': nrm(7, (N_EVEN, D_MODEL, AB_IN), D_MODEL ** -0.5),
        'ab_w_out': nrm(8, (N_EVEN, A_WIDTH + B_WIDTH, D_MODEL), (A_WIDTH + B_WIDTH) ** -0.5),
        'a_q_norm': gain(9, (N_EVEN, HEAD_DIM)),
        'a_k_norm': gain(10, (N_EVEN, HEAD_DIM)),
        'a_lambda_q1': nrm(11, (N_EVEN, HEAD_DIM), 0.1),
        'a_lambda_k1': nrm(12, (N_EVEN, HEAD_DIM), 0.1),
        'a_lambda_q2': nrm(13, (N_EVEN, HEAD_DIM), 0.1),
        'a_lambda_k2': nrm(14, (N_EVEN, HEAD_DIM), 0.1),
        'a_sub_norm': gain(15, (N_EVEN, A_V_DIM)),
        'b_q_norm': gain(16, (N_EVEN, HEAD_DIM)),
        'b_k_norm': gain(17, (N_EVEN, HEAD_DIM)),
        'b_rpb': nrm(18, (N_EVEN, B_HEADS, 2 * NA_ROWS_MAX - 1, 2 * NA_COLS - 1), 0.1),
        'c_w_in': nrm(19, (N_ODD, D_MODEL, C_IN), D_MODEL ** -0.5),
        'c_w_out': nrm(20, (N_ODD, C_HEADS * HEAD_DIM, D_MODEL), (C_HEADS * HEAD_DIM) ** -0.5),
        'c_q_norm': gain(21, (N_ODD, HEAD_DIM)),
        'c_k_norm': gain(22, (N_ODD, HEAD_DIM)),
        'ffn2_norm': gain(23, (DEPTH, D_MODEL)),
        'ffn2_w_gate': nrm(24, (DEPTH, D_MODEL, D_FF), D_MODEL ** -0.5),
        'ffn2_w_up': nrm(25, (DEPTH, D_MODEL, D_FF), D_MODEL ** -0.5),
        'ffn2_w_down': nrm(26, (DEPTH, D_FF, D_MODEL), D_FF ** -0.5),
        'final_norm': gain(27, (DEPTH, D_MODEL)),
    }


def reference(x_prompt, x_sample, ffn1_norm, ffn1_w_gate, ffn1_w_up, ffn1_w_down, mix_norm,
              ab_w_in, ab_w_out, a_q_norm, a_k_norm, a_lambda_q1, a_lambda_k1, a_lambda_q2, a_lambda_k2,
              a_sub_norm, b_q_norm, b_k_norm, b_rpb, c_w_in, c_w_out, c_q_norm, c_k_norm,
              ffn2_norm, ffn2_w_gate, ffn2_w_up, ffn2_w_down, final_norm):
    weights = (ffn1_norm, ffn1_w_gate, ffn1_w_up, ffn1_w_down, mix_norm,
               ab_w_in, ab_w_out, a_q_norm, a_k_norm, a_lambda_q1, a_lambda_k1, a_lambda_q2, a_lambda_k2,
               a_sub_norm, b_q_norm, b_k_norm, b_rpb, c_w_in, c_w_out, c_q_norm, c_k_norm,
               ffn2_norm, ffn2_w_gate, ffn2_w_up, ffn2_w_down, final_norm)
    y_prompt = trunk(x_prompt, *weights)
    y_sample = trunk(x_sample, *weights)
    return (y_prompt, y_sample)
```

```cpp
#include <hip/hip_runtime.h>
#include <cstdio>
#include <cstdint>
#include <cmath>
namespace pg8 {
#define PG8_LAS __attribute__((address_space(3)))
typedef unsigned short bf16_t;
typedef short bf16x8 __attribute__((ext_vector_type(8)));
typedef float f32x4 __attribute__((ext_vector_type(4)));
typedef unsigned u32x4 __attribute__((ext_vector_type(4)));
constexpr int BM = 256, BK = 64, HALF = 128, HTB = HALF * BK * 2  , STAGE_BYTES = 8 * HTB, NXCD = 8, WGM = 8;

__host__ __device__ __forceinline__ int lds_byte(int r, int c) { const int st = (r >> 4) * 2 + (c >> 5), rr = r & 15, cc = c & 31, ob = rr * 64 + cc * 2; return st * 1024 + (ob ^ (((ob >> 9) & 1) << 5)); }
__host__ __device__ __forceinline__ void stage_rc(int b, int& R, int& C) { const int st = b / 1024, sb = b % 1024, swz = sb ^ (((sb >> 9) & 1) << 5); R = (st >> 1) * 16 + swz / 64; C = (st & 1) * 32 + (swz % 64) / 2; }
__host__ __device__ __forceinline__ int perm32(int rho) { const int n = rho >> 4, i = rho & 15; return 8 * (i >> 2) + 4 * n + (i & 3); }

struct Unit { int pm, pn; };
struct Gemm { const bf16_t* A; const bf16_t* Bt; int M, N, K; };

struct StaticOrder {
    int nM, nN, nwg, G, c;
    __host__ __device__ void init(int M, int N, int G_, int c_) { nM = M / BM; nN = N / BM; nwg = nM * nN; G = G_; c = c_; }
    __host__ __device__ bool next(int i, Unit& u) const {
        const long L = (long)i * G + c; if (L >= nwg) return false;
        int wgid = (int)L; { const int q = nwg / NXCD, r = nwg % NXCD, xcd = wgid % NXCD, off = wgid / NXCD; wgid = (xcd < r ? xcd * (q + 1) : r * (q + 1) + (xcd - r) * q) + off; }
        const int nig = WGM * nN, gid = wgid / nig, fm = gid * WGM, gsz = (nM - fm) < WGM ? (nM - fm) : WGM;
        u.pm = fm + ((wgid % nig) % gsz); u.pn = (wgid % nig) / gsz; return true;
    }
    __device__ __forceinline__ void a_ready(const Unit&) const {}
    __device__ __forceinline__ void done(const Unit&) const {}
};

__device__ __forceinline__ unsigned cvt_pk_bf16(float lo, float hi) { unsigned r; asm volatile("v_cvt_pk_bf16_f32 %0, %1, %2" : "=v"(r) : "v"(lo), "v"(hi)); return r; }
typedef float f32x2 __attribute__((ext_vector_type(2)));
__device__ __forceinline__ f32x2 gelu_pk(f32x2 v) {
    const f32x2 av = __builtin_elementwise_abs(v), d = av * 0.2316418882f + 1.0f;
    f32x2 t; t.x = __builtin_amdgcn_rcpf(d.x); t.y = __builtin_amdgcn_rcpf(d.y);
    f32x2 q = t * 0.5307027145f + (-0.7265760135f); q = q * t + 0.7107068705f; q = q * t + (-0.142248368f); q = q * t + 0.127414796f; q = q * t;
    const f32x2 s = (v * v) * (-0.72134752044f);
    f32x2 e; e.x = __builtin_amdgcn_exp2f(s.x); e.y = __builtin_amdgcn_exp2f(s.y);
    const f32x2 m = v * (q * e), r = v - m;
    f32x2 o; o.x = v.x < 0.f ? m.x : r.x; o.y = v.y < 0.f ? m.y : r.y; return o;
}

template <int ACT  > struct EpiBf16 {
    static constexpr bool PERM = true, AFTER_DRAIN = false; static_assert(ACT == 0 || ACT == 1, "EpiBf16: ACT is 0 (none) or 1 (gelu_pk)");
    bf16_t* O; int ldc; const float* bias; int split_cols; size_t split_stride; float scale0;
    __device__ __forceinline__ void operator()(const f32x4 (&acc)[2][2][4][2], const Unit& u, int wr, int wc, int fr, int fq) const {
        const int row0 = u.pm * BM + wr * 64 + fr; int colt = u.pn * BM; bf16_t* base = O;
        float sc = 1.f; if (split_cols) { const int t = colt / split_cols; base += (size_t)t * split_stride; colt -= t * split_cols; if (t == 0) sc = scale0; }
        const int col0 = colt + wc * 32 + 8 * fq, bcol0 = u.pn * BM + wc * 32 + 8 * fq;
        f32x4 bv[2][2];
#pragma unroll
        for (int bj = 0; bj < 2; ++bj)
#pragma unroll
            for (int n = 0; n < 2; ++n) bv[bj][n] = bias ? *(const f32x4*)(bias + bcol0 + bj * HALF + 4 * n) : (f32x4){0.f, 0.f, 0.f, 0.f};
#pragma unroll
        for (int ai = 0; ai < 2; ++ai)
#pragma unroll
            for (int m = 0; m < 4; ++m) { bf16_t* rowp = base + (size_t)(row0 + ai * HALF + m * 16) * ldc + col0;
#pragma unroll
                for (int bj = 0; bj < 2; ++bj) { f32x4 v0 = acc[ai][bj][m][0] + bv[bj][0], v1 = acc[ai][bj][m][1] + bv[bj][1];
                    if (ACT == 1) { f32x2 a = gelu_pk((f32x2){v0[0], v0[1]}), b = gelu_pk((f32x2){v0[2], v0[3]}), c = gelu_pk((f32x2){v1[0], v1[1]}), d = gelu_pk((f32x2){v1[2], v1[3]});
                        v0 = (f32x4){a.x, a.y, b.x, b.y}; v1 = (f32x4){c.x, c.y, d.x, d.y}; }
                    v0 = v0 * sc; v1 = v1 * sc; u32x4 w; w.x = cvt_pk_bf16(v0[0], v0[1]); w.y = cvt_pk_bf16(v0[2], v0[3]); w.z = cvt_pk_bf16(v1[0], v1[1]); w.w = cvt_pk_bf16(v1[2], v1[3]);
                    *(u32x4*)(rowp + bj * HALF) = w; } }
    }
};

struct EpiSwiglu {
    static constexpr bool PERM = true, AFTER_DRAIN = false;
    bf16_t* H; int ldh;
    __device__ __forceinline__ void operator()(const f32x4 (&acc)[2][2][4][2], const Unit& u, int wr, int wc, int fr, int fq) const {
        const int row0 = u.pm * BM + wr * 64 + fr; const int col0 = u.pn * HALF + wc * 32 + 8 * fq;
#pragma unroll
        for (int ai = 0; ai < 2; ++ai)
#pragma unroll
            for (int m = 0; m < 4; ++m) { bf16_t* rowp = H + (size_t)(row0 + ai * HALF + m * 16) * ldh + col0;
                float hv[8];
#pragma unroll
                for (int n = 0; n < 2; ++n)
#pragma unroll
                    for (int e = 0; e < 4; ++e) { const float g = acc[ai][0][m][n][e], up = acc[ai][1][m][n][e];
                        const float sg = __builtin_amdgcn_rcpf(1.0f + __builtin_amdgcn_exp2f(-1.4426950408889634f * g));
                        hv[n * 4 + e] = g * sg * up; }
                u32x4 w; w.x = cvt_pk_bf16(hv[0], hv[1]); w.y = cvt_pk_bf16(hv[2], hv[3]); w.z = cvt_pk_bf16(hv[4], hv[5]); w.w = cvt_pk_bf16(hv[6], hv[7]);
                *(u32x4*)rowp = w; }
    }
};
struct EpiRes {
    static constexpr bool PERM = true, AFTER_DRAIN = false;
    float* X; int ldc; float alpha;
    __device__ __forceinline__ void operator()(const f32x4 (&acc)[2][2][4][2], const Unit& u, int wr, int wc, int fr, int fq) const {
        const int row0 = u.pm * BM + wr * 64 + fr; const int col0 = u.pn * BM + wc * 32 + 8 * fq;
#pragma unroll
        for (int ai = 0; ai < 2; ++ai)
#pragma unroll
            for (int m = 0; m < 4; ++m) { float* rowp = X + (size_t)(row0 + ai * HALF + m * 16) * ldc + col0;
#pragma unroll
                for (int bj = 0; bj < 2; ++bj) { f32x4 a = *(const f32x4*)(rowp + bj * HALF), b = *(const f32x4*)(rowp + bj * HALF + 4);
                    a += acc[ai][bj][m][0] * alpha; b += acc[ai][bj][m][1] * alpha;
                    *(f32x4*)(rowp + bj * HALF) = a; *(f32x4*)(rowp + bj * HALF + 4) = b; } }
    }
};
template <class Epi, class Sched, bool ALIGN_EPI = false, bool SP2 = false>
__device__ __forceinline__ void gemm_phase(PG8_LAS unsigned char* lds, const Gemm g, const Sched& S, const Epi& E) {
    int tid_ = threadIdx.x; asm volatile("" : "+v"(tid_));
    const int tid = tid_, wid = __builtin_amdgcn_readfirstlane(tid >> 6), lane = tid & 63, wr = wid >> 2, wc = wid & 3, fr = lane & 15, fq = lane >> 4;
    const int K = g.K, nt = K / BK;
    unsigned voffA[2], voffB[2];
#pragma unroll
    for (int i = 0; i < 2; ++i) { int R, C; stage_rc(tid * 16 + i * 8192, R, C); const int Rb = Epi::PERM ? ((R & ~31) + perm32(R & 31)) : R;
        voffA[i] = (unsigned)(R * K + C) * 2u; voffB[i] = (unsigned)(Rb * K + C) * 2u; }
    const size_t kstep = (size_t)(BK * 2);
    const size_t hstep = (size_t)HALF * K * 2;
    const size_t tstep = 2 * hstep;
    const unsigned ldsw = (unsigned)wid * 1024u;
    const int aoff = lds_byte(wr * 64 + fr, fq * 8), boff = lds_byte(wc * 32 + fr, fq * 8);
#define PG8_SA(b, h) (((b) * 2 + (h)) * HTB)
#define PG8_SB(b, h) ((4 + (b) * 2 + (h)) * HTB)
#define PG8_STAGE(bufoff, gbase, voff) do { _Pragma("unroll") for (int _i = 0; _i < 2; ++_i) \
        __builtin_amdgcn_global_load_lds((const unsigned*)((const char*)(gbase) + (voff)[_i]), (PG8_LAS unsigned*)(lds + (bufoff) + ldsw + _i * 8192), 16, 0, 0); } while (0)
#define PG8_LDA(dst, b, h) do { _Pragma("unroll") for (int m = 0; m < 4; ++m) _Pragma("unroll") for (int k = 0; k < 2; ++k) dst[m][k] = *(const PG8_LAS bf16x8*)(lds + PG8_SA(b, h) + aoff + m * 2048 + k * 1024); } while (0)
#define PG8_LDB(dst, b, h) do { _Pragma("unroll") for (int n = 0; n < 2; ++n) _Pragma("unroll") for (int k = 0; k < 2; ++k) dst[n][k] = *(const PG8_LAS bf16x8*)(lds + PG8_SB(b, h) + boff + n * 2048 + k * 1024); } while (0)
#define PG8_MMA(ai, bj, At, Bt) do { __builtin_amdgcn_s_setprio(1); _Pragma("unroll") for (int m = 0; m < 4; ++m) _Pragma("unroll") for (int n = 0; n < 2; ++n) _Pragma("unroll") for (int k = 0; k < 2; ++k) \
        acc[ai][bj][m][n] = __builtin_amdgcn_mfma_f32_16x16x32_bf16(Bt[n][k], At[m][k], acc[ai][bj][m][n], 0, 0, 0); __builtin_amdgcn_s_setprio(0); } while (0)
#define PG8_WAIT_V(n) asm volatile("s_waitcnt vmcnt(" #n ")" ::: "memory")
#define PG8_WAIT_L(n) asm volatile("s_waitcnt lgkmcnt(" #n ")" ::: "memory")
#define PG8_BAR __builtin_amdgcn_s_barrier()
#define PG8_SCHED __builtin_amdgcn_sched_barrier(0)
    Unit cur, nxt; int ui = 0;
    if (!S.next(0, cur)) return;
    f32x4 acc[2][2][4][2];
#pragma unroll
    for (int a = 0; a < 2; ++a)
#pragma unroll
        for (int b = 0; b < 2; ++b)
#pragma unroll
            for (int m = 0; m < 4; ++m)
#pragma unroll
                for (int n = 0; n < 2; ++n) acc[a][b][m][n] = (f32x4){0.f, 0.f, 0.f, 0.f};
    bf16x8 At[4][2], B0[2][2], B1[2][2];
    const char* cA = (const char*)g.A + (size_t)cur.pm * tstep; const char* cB = (const char*)g.Bt + (size_t)cur.pn * tstep;
    S.a_ready(cur);
    if constexpr (SP2) {
        PG8_STAGE(PG8_SB(0, 0), cB, voffB); PG8_STAGE(PG8_SB(0, 1), cB + hstep, voffB); PG8_STAGE(PG8_SA(0, 0), cA, voffA); PG8_STAGE(PG8_SA(0, 1), cA + hstep, voffA);
        if (wr == 1) PG8_BAR;
        PG8_WAIT_V(2); PG8_BAR;
        PG8_STAGE(PG8_SB(1, 0), cB + kstep, voffB); PG8_STAGE(PG8_SA(1, 0), cA + kstep, voffA); PG8_STAGE(PG8_SB(1, 1), cB + hstep + kstep, voffB);
        PG8_WAIT_V(6); PG8_BAR;
    } else {
        PG8_STAGE(PG8_SB(0, 0), cB, voffB); PG8_STAGE(PG8_SA(0, 0), cA, voffA); PG8_STAGE(PG8_SB(0, 1), cB + hstep, voffB); PG8_STAGE(PG8_SA(0, 1), cA + hstep, voffA);
        if (wr == 1) PG8_BAR;
        PG8_WAIT_V(4); PG8_BAR;
        PG8_STAGE(PG8_SB(1, 0), cB + kstep, voffB); PG8_STAGE(PG8_SA(1, 0), cA + kstep, voffA); PG8_STAGE(PG8_SB(1, 1), cB + hstep + kstep, voffB);
        PG8_WAIT_V(6); PG8_BAR;
    }
    for (;;) {
        const bool has_next = S.next(ui + 1, nxt);
        const char* nA = has_next ? (const char*)g.A + (size_t)nxt.pm * tstep : cA; const char* nB = has_next ? (const char*)g.Bt + (size_t)nxt.pn * tstep : cB;
        for (int t = 0; t < nt; t += 2) {
            const bool last = (t == nt - 2);
            const char* a1 = cA + (size_t)(t + 1) * kstep;
            const char* a2 = last ? nA : cA + (size_t)(t + 2) * kstep; const char* b2 = last ? nB : cB + (size_t)(t + 2) * kstep;
            const char* a3 = a2 + kstep; const char* b3 = b2 + kstep;
            if (last && has_next) S.a_ready(nxt);
            if constexpr (SP2) {
            PG8_LDB(B0, 0, 0); PG8_LDB(B1, 0, 1); PG8_SCHED; PG8_LDA(At, 0, 0); PG8_STAGE(PG8_SA(1, 1), a1 + hstep, voffA);
            PG8_WAIT_V(8); PG8_WAIT_L(0); PG8_BAR; PG8_MMA(0, 0, At, B0); PG8_MMA(0, 1, At, B1); PG8_BAR; PG8_SCHED;
            PG8_LDA(At, 0, 1); PG8_STAGE(PG8_SB(0, 0), b2, voffB); PG8_STAGE(PG8_SB(0, 1), b2 + hstep, voffB); PG8_STAGE(PG8_SA(0, 0), a2, voffA);
            PG8_WAIT_V(8); PG8_WAIT_L(0); PG8_BAR; PG8_MMA(1, 0, At, B0); PG8_MMA(1, 1, At, B1); PG8_BAR; PG8_SCHED;
            PG8_LDB(B0, 1, 0); PG8_LDB(B1, 1, 1); PG8_SCHED; PG8_LDA(At, 1, 0); PG8_STAGE(PG8_SA(0, 1), a2 + hstep, voffA);
            PG8_WAIT_V(8); PG8_WAIT_L(0); PG8_BAR; PG8_MMA(0, 0, At, B0); PG8_MMA(0, 1, At, B1); PG8_BAR; PG8_SCHED;
            PG8_LDA(At, 1, 1); PG8_STAGE(PG8_SB(1, 0), b3, voffB); PG8_STAGE(PG8_SB(1, 1), b3 + hstep, voffB); PG8_STAGE(PG8_SA(1, 0), a3, voffA);
            PG8_WAIT_V(8); PG8_WAIT_L(0); PG8_BAR; PG8_MMA(1, 0, At, B0); PG8_MMA(1, 1, At, B1); PG8_BAR; PG8_SCHED;
            } else {
            PG8_LDB(B0, 0, 0); PG8_SCHED; PG8_LDA(At, 0, 0); PG8_STAGE(PG8_SA(1, 1), a1 + hstep, voffA);
            PG8_WAIT_L(8); PG8_BAR; PG8_WAIT_L(0); PG8_MMA(0, 0, At, B0); PG8_BAR; PG8_SCHED;
            PG8_LDB(B1, 0, 1); PG8_STAGE(PG8_SB(0, 0), b2, voffB);
            PG8_BAR; PG8_WAIT_L(0); PG8_MMA(0, 1, At, B1); PG8_BAR;
            PG8_LDA(At, 0, 1); PG8_STAGE(PG8_SA(0, 0), a2, voffA);
            PG8_BAR; PG8_WAIT_L(0); PG8_MMA(1, 0, At, B0); PG8_BAR; PG8_SCHED;
            PG8_STAGE(PG8_SB(0, 1), b2 + hstep, voffB);
            PG8_WAIT_V(6); PG8_BAR; PG8_MMA(1, 1, At, B1); PG8_BAR;
            PG8_LDB(B0, 1, 0); PG8_SCHED; PG8_LDA(At, 1, 0); PG8_STAGE(PG8_SA(0, 1), a2 + hstep, voffA);
            PG8_WAIT_L(8); PG8_BAR; PG8_WAIT_L(0); PG8_MMA(0, 0, At, B0); PG8_BAR; PG8_SCHED;
            PG8_LDB(B1, 1, 1); PG8_STAGE(PG8_SB(1, 0), b3, voffB);
            PG8_BAR; PG8_WAIT_L(0); PG8_MMA(0, 1, At, B1); PG8_BAR;
            PG8_LDA(At, 1, 1); PG8_STAGE(PG8_SA(1, 0), a3, voffA);
            PG8_BAR; PG8_WAIT_L(0); PG8_MMA(1, 0, At, B0); PG8_BAR; PG8_SCHED;
            PG8_STAGE(PG8_SB(1, 1), b3 + hstep, voffB);
            PG8_WAIT_V(6); PG8_BAR; PG8_MMA(1, 1, At, B1); PG8_BAR;
            }
        }
        if constexpr (ALIGN_EPI) { if (wr == 0) PG8_BAR; }
        if constexpr (!Epi::AFTER_DRAIN) { E(acc, cur, wr, wc, fr, fq); S.done(cur); }
        if (!has_next) break;
#pragma unroll
        for (int a = 0; a < 2; ++a)
#pragma unroll
            for (int b = 0; b < 2; ++b)
#pragma unroll
                for (int m = 0; m < 4; ++m)
#pragma unroll
                    for (int n = 0; n < 2; ++n) acc[a][b][m][n] = (f32x4){0.f, 0.f, 0.f, 0.f};
        cur = nxt; cA = nA; cB = nB; ++ui;
        if constexpr (ALIGN_EPI) { if (wr == 1) PG8_BAR; }
    }
    PG8_WAIT_V(0);
    if constexpr (!ALIGN_EPI) { if (wr == 0) PG8_BAR; }
    PG8_BAR;
    if constexpr (Epi::AFTER_DRAIN) { E.fused(acc, cur, wr, wc, fr, fq, lds, wid, lane); S.done(cur); }
#undef PG8_SA
#undef PG8_SB
#undef PG8_STAGE
#undef PG8_LDA
#undef PG8_LDB
#undef PG8_MMA
#undef PG8_WAIT_V
#undef PG8_WAIT_L
#undef PG8_BAR
#undef PG8_SCHED
}
}
#define N_LAUNCH_MODE 0

#include <hip/hip_cooperative_groups.h>
namespace cg = cooperative_groups;

#define LAS __attribute__((address_space(3)))
typedef unsigned short bf16;
typedef float f32x4 __attribute__((ext_vector_type(4)));
typedef float f32x16 __attribute__((ext_vector_type(16)));
typedef short bf16x8 __attribute__((ext_vector_type(8)));
typedef short s16x4 __attribute__((ext_vector_type(4)));
typedef short v4i16_t __attribute__((ext_vector_type(4)));
typedef unsigned u32x4 __attribute__((ext_vector_type(4)));
typedef unsigned u32x2 __attribute__((ext_vector_type(2)));
typedef float f32x2_t __attribute__((ext_vector_type(2)));
typedef __bf16 bf16x2_t __attribute__((ext_vector_type(2)));

constexpr int NTOK = 98304, NPROMPT = 65536, DM = 1024, DFF = 2816, SEQ = 2048, NBATCH = 48;
constexpr int LD0 = 3072, LD1 = 1536;
constexpr float EPS = 1e-6f, L2E = 1.4426950408889634f;
constexpr float QSCALE = 0.125f * L2E;
constexpr int NWAVES = 8, NTHREADS = 512;
constexpr int LDS_BYTES = 147456;
constexpr int NPHASES = 23;

constexpr size_t MiB = 1u << 20;
constexpr size_t SZ_GU = (size_t)2 * DFF * DM * 2, SZ_D = (size_t)DM * DFF * 2, SZ_FFN = SZ_GU + SZ_D;
constexpr size_t WS_FFN = 0;
constexpr size_t WS_ABIN = 4 * SZ_FFN, WS_ABOUT = WS_ABIN + (size_t)LD0 * DM * 2, WS_CIN = WS_ABOUT + (size_t)DM * DM * 2, WS_COUT = WS_CIN + (size_t)LD1 * DM * 2;
constexpr size_t WS_WEND = WS_COUT + (size_t)DM * DM * 2;
constexpr size_t WS_XN = 96 * MiB;
constexpr size_t WS_BIG = 288 * MiB;
constexpr size_t WS_STASH = 864 * MiB;
constexpr size_t WS_END = 928 * MiB;
static_assert(WS_WEND <= WS_XN && WS_XN + (size_t)NTOK * DM * 2 <= WS_BIG && WS_BIG + (size_t)NTOK * LD0 * 2 <= WS_END, "d_ws map");

struct Args { const float* in[28]; float* out; unsigned char* ws; int lo, hi, grid, pad; };
__device__ __forceinline__ int opaque_bid() { int b = blockIdx.x; asm volatile("" : "+s"(b)); return b; }
typedef const __attribute__((address_space(4))) Args* KArgs;
__device__ __forceinline__ KArgs kargs() { KArgs p = (KArgs)__builtin_amdgcn_kernarg_segment_ptr(); asm volatile("" : "+s"(p)); return p; }
#define inp(a_, i_) (kargs()->in[(i_)])
#define WSP (kargs()->ws)

__device__ __forceinline__ float wave_sum(float v) {
#pragma unroll
    for (int o = 1; o < 64; o <<= 1) v += __shfl_xor(v, o);
    return v;
}
__device__ __forceinline__ unsigned cvtpk(float lo, float hi) { f32x2_t v = {lo, hi}; bf16x2_t b = __builtin_convertvector(v, bf16x2_t); return __builtin_bit_cast(unsigned, b); }
__device__ __forceinline__ float bf2f(unsigned short h) { return __uint_as_float((unsigned)h << 16); }
__device__ __forceinline__ int clampi(int v, int lo, int hi) { return v < lo ? lo : (v > hi ? hi : v); }

__device__ __forceinline__ void tr_item(const float* W, int K, int N, bf16* WT, int mode, LAS float* scr, int item, int lane) {
    const int nblk = N / 32, kb = item / nblk, nb = item % nblk, k0 = 64 * kb, n0 = 32 * nb;
    const int drow0 = (mode == 0) ? n0 : ((n0 >> 7) * 256 + (n0 & 127) + (mode == 2 ? 128 : 0));
#pragma unroll 8
    for (int i = 0; i < 32; ++i) { const int kk = 2 * i + (lane >> 5); scr[kk * 33 + (lane & 31)] = W[(size_t)(k0 + kk) * N + n0 + (lane & 31)]; }
    asm volatile("s_waitcnt lgkmcnt(0)" ::: "memory");
    const int c = lane & 7;
#pragma unroll
    for (int j = 0; j < 4; ++j) { const int n = (lane >> 3) + 8 * j; const LAS float* s = scr + (8 * c) * 33 + n;
        u32x4 o; o.x = cvtpk(s[0 * 33], s[1 * 33]); o.y = cvtpk(s[2 * 33], s[3 * 33]); o.z = cvtpk(s[4 * 33], s[5 * 33]); o.w = cvtpk(s[6 * 33], s[7 * 33]);
        *(u32x4*)(WT + (size_t)(drow0 + n) * K + k0 + 8 * c) = o; }
    asm volatile("s_waitcnt lgkmcnt(0)" ::: "memory");
}

__device__ __forceinline__ void convert_weights(const Args& a, LAS unsigned char* lds, int gw, int ngw, int wave, int lane) {
    LAS float* scr = (LAS float*)(lds + wave * 16384);
    constexpr int I_F = (DM / 64) * (DFF / 32);
    constexpr int I_FFN = 4 * 3 * I_F;
    constexpr int I_ABIN = (DM / 64) * (LD0 / 32), I_SQ = (DM / 64) * (DM / 32), I_CIN = (DM / 64) * (LD1 / 32);
    constexpr int NITEMS = I_FFN + I_ABIN + I_SQ + I_CIN + I_SQ;
    for (int it = gw; it < NITEMS; it += ngw) {
        if (it < I_FFN) {
            const int i = it / (3 * I_F), r = it % (3 * I_F), which = r / I_F, item = r % I_F, l = i >> 1, f = i & 1;
            bf16* gu = (bf16*)(WSP + WS_FFN + (size_t)i * SZ_FFN); bf16* dn = (bf16*)(WSP + WS_FFN + (size_t)i * SZ_FFN + SZ_GU);
            const size_t woff = (size_t)l * DM * DFF;
            if (which == 0)      tr_item(inp(a, f ? 24 : 3) + woff, DM, DFF, gu, 1, scr, item, lane);
            else if (which == 1) tr_item(inp(a, f ? 25 : 4) + woff, DM, DFF, gu, 2, scr, item, lane);
            else                 tr_item(inp(a, f ? 26 : 5) + woff, DFF, DM, dn, 0, scr, item, lane);
            continue;
        }
        int r = it - I_FFN;
        if (r < I_ABIN) { tr_item(inp(a, 7), DM, LD0, (bf16*)(WSP + WS_ABIN), 0, scr, r, lane); continue; } r -= I_ABIN;
        if (r < I_SQ) { tr_item(inp(a, 8), DM, DM, (bf16*)(WSP + WS_ABOUT), 0, scr, r, lane); continue; } r -= I_SQ;
        if (r < I_CIN) { tr_item(inp(a, 19), DM, LD1, (bf16*)(WSP + WS_CIN), 0, scr, r, lane); continue; } r -= I_CIN;
        tr_item(inp(a, 20), DM, DM, (bf16*)(WSP + WS_COUT), 0, scr, r, lane);
    }
}

__device__ __forceinline__ void norm_phase(const float* xp, const float* xs, const float* g1, const float* g2, float* of32, bf16* obf, int mode, int gw, int ngw, int lane) {
    f32x4 ga[4], gb[4];
#pragma unroll
    for (int j = 0; j < 4; ++j) { ga[j] = *(const f32x4*)(g1 + 4 * lane + 256 * j); gb[j] = (mode == 2) ? *(const f32x4*)(g2 + 4 * lane + 256 * j) : (f32x4){0.f, 0.f, 0.f, 0.f}; }
    for (int m = gw; m < NTOK; m += ngw) {
        const float* xrow = (mode == 1 && m >= NPROMPT) ? xs + (size_t)(m - NPROMPT) * DM : xp + (size_t)m * DM;
        f32x4 v[4]; float ss = 0.f;
#pragma unroll
        for (int j = 0; j < 4; ++j) { v[j] = *(const f32x4*)(xrow + 4 * lane + 256 * j); ss += (v[j].x * v[j].x + v[j].y * v[j].y) + (v[j].z * v[j].z + v[j].w * v[j].w); }
        const float rstd = 1.0f / sqrtf(wave_sum(ss) * (1.0f / DM) + EPS);
        f32x4 y[4];
#pragma unroll
        for (int j = 0; j < 4; ++j) y[j] = v[j] * rstd * ga[j];
        if (mode == 1) {
#pragma unroll
            for (int j = 0; j < 4; ++j) *(f32x4*)(of32 + (size_t)m * DM + 4 * lane + 256 * j) = v[j];
        }
        if (mode >= 2) {
#pragma unroll
            for (int j = 0; j < 4; ++j) *(f32x4*)(of32 + (size_t)m * DM + 4 * lane + 256 * j) = y[j];
        }
        if (mode == 2) {
            float s2 = 0.f;
#pragma unroll
            for (int j = 0; j < 4; ++j) s2 += (y[j].x * y[j].x + y[j].y * y[j].y) + (y[j].z * y[j].z + y[j].w * y[j].w);
            const float r2 = 1.0f / sqrtf(wave_sum(s2) * (1.0f / DM) + EPS);
#pragma unroll
            for (int j = 0; j < 4; ++j) y[j] = y[j] * r2 * gb[j];
        }
        if (mode != 3) {
#pragma unroll
            for (int j = 0; j < 4; ++j) { u32x2 w; w.x = cvtpk(y[j].x, y[j].y); w.y = cvtpk(y[j].z, y[j].w); *(u32x2*)(obf + (size_t)m * DM + 4 * lane + 256 * j) = w; }
        }
    }
}

__device__ __forceinline__ void qknorm_phase(const Args& a, int layer, bf16* qkv, int gtid, int gthreads, int lane) {
    const int cpr = layer == 0 ? 256 : 160, ld = layer == 0 ? LD0 : LD1;
    const long total = (long)NTOK * cpr;
    const int l8 = lane & 7;
    for (long idx = gtid; idx < total; idx += gthreads) {
        const int m = (int)(idx / cpr), ch = (int)(idx % cpr);
        int col; const float* g; bool isq;
        if (layer == 0) { col = ch < 128 ? ch * 8 : 1536 + (ch - 128) * 8;
            if (col < 512) { g = inp(a, 9); isq = true; } else if (col < 1024) { g = inp(a, 10); isq = false; } else if (col < 2048) { g = inp(a, 16); isq = true; } else { g = inp(a, 17); isq = false; } }
        else { col = ch * 8; if (col < 1024) { g = inp(a, 21); isq = true; } else { g = inp(a, 22); isq = false; } }
        bf16* p = qkv + (size_t)m * ld + col;
        const u32x4 raw = *(const u32x4*)p;
        float x[8];
#pragma unroll
        for (int j = 0; j < 4; ++j) { x[2 * j] = __uint_as_float(raw[j] << 16); x[2 * j + 1] = __uint_as_float(raw[j] & 0xffff0000u); }
        float ss = 0.f;
#pragma unroll
        for (int j = 0; j < 8; ++j) ss += x[j] * x[j];
        ss += __shfl_xor(ss, 1); ss += __shfl_xor(ss, 2); ss += __shfl_xor(ss, 4);
        const float rstd = 1.0f / sqrtf(ss * (1.0f / 64.0f) + EPS);
        const f32x4 g0 = *(const f32x4*)(g + l8 * 8), g1v = *(const f32x4*)(g + l8 * 8 + 4);
        x[0] *= rstd * g0.x; x[1] *= rstd * g0.y; x[2] *= rstd * g0.z; x[3] *= rstd * g0.w;
        x[4] *= rstd * g1v.x; x[5] *= rstd * g1v.y; x[6] *= rstd * g1v.z; x[7] *= rstd * g1v.w;
        if (layer == 1) {
            const int t = m & (SEQ - 1);
            const float pos = (float)((l8 >> 2) ? (t & 63) : (t >> 6));
            const bool second = (l8 >> 1) & 1;
#pragma unroll
            for (int j = 0; j < 8; ++j) {
                const int i = (l8 & 1) * 8 + j;
                const float invf = __builtin_amdgcn_exp2f(-(float)i * (13.287712379549449f / 16.0f));
                const float ang = pos * invf;
                const float cs = __cosf(ang), sn = __sinf(ang);
                const float other = __shfl_xor(x[j], 2);
                x[j] = second ? (x[j] * cs + other * sn) : (x[j] * cs - other * sn);
            }
        }
        const float sc = isq ? QSCALE : 1.0f;
        u32x4 w; w.x = cvtpk(x[0] * sc, x[1] * sc); w.y = cvtpk(x[2] * sc, x[3] * sc); w.z = cvtpk(x[4] * sc, x[5] * sc); w.w = cvtpk(x[6] * sc, x[7] * sc);
        *(u32x4*)p = w;
    }
}

__device__ __forceinline__ int crow(int r, int hi) { return (r & 3) + 8 * (r >> 2) + 4 * hi; }
__device__ __forceinline__ s16x4 vtr(const LAS unsigned char* p) { return __builtin_bit_cast(s16x4, __builtin_amdgcn_ds_read_tr16_b64_v4i16((LAS v4i16_t*)p)); }
#define MFMA32(a, b, c) __builtin_amdgcn_mfma_f32_32x32x16_bf16((a), (b), (c), 0, 0, 0)

struct ModNone {
    __device__ __forceinline__ bool active(int) const { return true; }
    __device__ __forceinline__ void apply(f32x16&, f32x16&, int) const {}
};
struct ModAlibi {
    float slope; int qpos, hi;
    __device__ __forceinline__ bool active(int) const { return true; }
    __device__ __forceinline__ void apply(f32x16& p0, f32x16& p1, int t) const {
        const float base = (float)(qpos - t * 64 - 4 * hi);
#pragma unroll
        for (int r = 0; r < 16; ++r) { const float off = (float)((r & 3) + 8 * (r >> 2));
            p0[r] -= slope * fabsf(base - off); p1[r] -= slope * fabsf(base - (off + 32.0f)); }
    }
};
struct ModNA {
    const float* rpb_h; int r, c, cs, rs, lo, hi;
    __device__ __forceinline__ bool active(int t) const { const int rid = lo + t; return rid >= rs && rid < rs + 8; }
    __device__ __forceinline__ void apply(f32x16& p0, f32x16& p1, int t) const {
        const float* brow = rpb_h + (lo + t - r + 7) * 31;
#pragma unroll
        for (int q = 0; q < 16; ++q) { const int kc = 4 * hi + (q & 3) + 8 * (q >> 2);
            { const int idx = clampi(kc - c + 15, 0, 30); const float bias = brow[idx] * L2E; p0[q] = ((unsigned)(kc - cs) < 16u) ? p0[q] + bias : -INFINITY; }
            { const int k2 = kc + 32; const int idx = clampi(k2 - c + 15, 0, 30); const float bias = brow[idx] * L2E; p1[q] = ((unsigned)(k2 - cs) < 16u) ? p1[q] + bias : -INFINITY; } }
    }
};

template <int DV, class Mod>
__device__ __forceinline__ void attn_loop(LAS unsigned char* lds, const bf16* Kg, const bf16* Vg, int ld, int nt,
                                          const bf16x8 (&qr)[4], f32x16 (&o)[DV / 32], float& m, float& l, const Mod& mod, int tid, int lane, int r32, int hi) {
    constexpr int KROW = 144, VROW = DV * 2 + 64, VOFF = 64 * KROW;
    const int lkv = tid >> 3, lch = tid & 7;
    const bf16* kp = Kg + (size_t)lkv * ld + lch * 8;
    const bf16* vp = Vg + (size_t)lkv * ld + lch * 8;
    u32x4 kreg = *(const u32x4*)kp, vreg0 = *(const u32x4*)vp, vreg1 = (u32x4){0u, 0u, 0u, 0u};
    if (DV == 128) vreg1 = *(const u32x4*)(vp + 64);
    LAS unsigned char* kdst = lds + lkv * KROW + lch * 16;
    LAS unsigned char* vdst = lds + VOFF + lkv * VROW + lch * 16;
    const LAS unsigned char* kfr = lds + r32 * KROW + hi * 16;
    const LAS unsigned char* vfr = lds + VOFF + (4 * hi + ((lane & 15) >> 2)) * VROW + (16 * ((lane >> 4) & 1) + 4 * (lane & 3)) * 2;
    for (int t = 0; t < nt; ++t) {
        __syncthreads();
        *(LAS u32x4*)kdst = kreg; *(LAS u32x4*)vdst = vreg0; if (DV == 128) *(LAS u32x4*)(vdst + 128) = vreg1;
        __syncthreads();
        if (t + 1 < nt) { const size_t adv = (size_t)(t + 1) * 64 * ld; kreg = *(const u32x4*)(kp + adv); vreg0 = *(const u32x4*)(vp + adv); if (DV == 128) vreg1 = *(const u32x4*)(vp + adv + 64); }
        if (mod.active(t)) {
            f32x16 p0 = {}, p1 = {};
#pragma unroll
            for (int d0 = 0; d0 < 4; ++d0) {
                const bf16x8 k0 = *(const LAS bf16x8*)(kfr + d0 * 32), k1 = *(const LAS bf16x8*)(kfr + 32 * KROW + d0 * 32);
                p0 = MFMA32(k0, qr[d0], p0); p1 = MFMA32(k1, qr[d0], p1);
            }
            mod.apply(p0, p1, t);
            float mx = fmaxf(p0[0], p1[0]);
#pragma unroll
            for (int r = 1; r < 16; ++r) mx = fmaxf(mx, fmaxf(p0[r], p1[r]));
            mx = fmaxf(mx, __shfl_xor(mx, 32));
            const float mn = fmaxf(m, mx), al = __builtin_amdgcn_exp2f(m - mn);
            m = mn;
            float rs = 0.f;
#pragma unroll
            for (int r = 0; r < 16; ++r) { p0[r] = __builtin_amdgcn_exp2f(p0[r] - mn); p1[r] = __builtin_amdgcn_exp2f(p1[r] - mn); rs += p0[r] + p1[r]; }
            l = l * al + rs;
#pragma unroll
            for (int db = 0; db < DV / 32; ++db) o[db] *= al;
            bf16x8 pa[4];
            { u32x4 w;
              w.x = cvtpk(p0[0], p0[1]); w.y = cvtpk(p0[2], p0[3]); w.z = cvtpk(p0[4], p0[5]); w.w = cvtpk(p0[6], p0[7]); pa[0] = __builtin_bit_cast(bf16x8, w);
              w.x = cvtpk(p0[8], p0[9]); w.y = cvtpk(p0[10], p0[11]); w.z = cvtpk(p0[12], p0[13]); w.w = cvtpk(p0[14], p0[15]); pa[1] = __builtin_bit_cast(bf16x8, w);
              w.x = cvtpk(p1[0], p1[1]); w.y = cvtpk(p1[2], p1[3]); w.z = cvtpk(p1[4], p1[5]); w.w = cvtpk(p1[6], p1[7]); pa[2] = __builtin_bit_cast(bf16x8, w);
              w.x = cvtpk(p1[8], p1[9]); w.y = cvtpk(p1[10], p1[11]); w.z = cvtpk(p1[12], p1[13]); w.w = cvtpk(p1[14], p1[15]); pa[3] = __builtin_bit_cast(bf16x8, w); }
#pragma unroll
            for (int db = 0; db < DV / 32; ++db)
#pragma unroll
                for (int c = 0; c < 4; ++c) {
                    const s16x4 lo4 = vtr(vfr + (16 * c) * VROW + db * 64), hi4 = vtr(vfr + (16 * c + 8) * VROW + db * 64);
                    const bf16x8 vf = (bf16x8){lo4[0], lo4[1], lo4[2], lo4[3], hi4[0], hi4[1], hi4[2], hi4[3]};
                    o[db] = MFMA32(vf, pa[c], o[db]);
                    if (DV == 128 && c == 3) __builtin_amdgcn_sched_barrier(0);
                }
        }
    }
}

__device__ __forceinline__ void load_q(bf16x8 (&qr)[4], const bf16* qrow, int hi) {
#pragma unroll
    for (int d0 = 0; d0 < 4; ++d0) qr[d0] = *(const bf16x8*)(qrow + d0 * 16 + hi * 8);
}
__device__ __forceinline__ void store_o32(bf16* dst  , const f32x16& v, int hi) {
#pragma unroll
    for (int g = 0; g < 4; ++g) { u32x2 w; w.x = cvtpk(v[4 * g], v[4 * g + 1]); w.y = cvtpk(v[4 * g + 2], v[4 * g + 3]); *(u32x2*)(dst + 8 * g + 4 * hi) = w; }
}

__device__ __forceinline__ void gqa_unit(LAS unsigned char* lds, const bf16* qkv, bf16* O, int b, int head, int qb, int tid, int wid, int lane) {
    asm volatile("" : "+v"(tid));
    lane = tid & 63; const int r32 = lane & 31, hi = lane >> 5;
    const size_t tok0 = (size_t)b * SEQ, qtok = tok0 + qb * 256 + wid * 32 + r32;
    bf16x8 qr[4]; load_q(qr, qkv + qtok * LD1 + head * 64, hi);
    const bf16* Kg = qkv + tok0 * LD1 + 1024 + (head >> 2) * 64;
    f32x16 o[2]; o[0] = (f32x16){}; o[1] = (f32x16){};
    float m = -1e30f, l = 0.f;
    ModNone mod;
    attn_loop<64, ModNone>(lds, Kg, Kg + 256, LD1, SEQ / 64, qr, o, m, l, mod, tid, lane, r32, hi);
    const float inv = 1.0f / (l + __shfl_xor(l, 32));
    bf16* orow = O + qtok * DM + head * 64;
    store_o32(orow, o[0] * inv, hi); store_o32(orow + 32, o[1] * inv, hi);
}

__device__ __forceinline__ void na_unit(LAS unsigned char* lds, const bf16* qkv, bf16* O, const float* rpb, int b, int h, int g, int tid, int wid, int lane) {
    asm volatile("" : "+v"(tid));
    lane = tid & 63; const int r32 = lane & 31, hi = lane >> 5;
    const int r = 4 * g + (wid >> 1), c = 32 * (wid & 1) + r32;
    const size_t tok0 = (size_t)b * SEQ, qtok = tok0 + r * 64 + c;
    const int lo = clampi(4 * g - 4, 0, 24), hirow = clampi(4 * g - 1, 0, 24) + 7;
    bf16x8 qr[4]; load_q(qr, qkv + qtok * LD0 + 1536 + h * 64, hi);
    const bf16* Kg = qkv + (tok0 + (size_t)lo * 64) * LD0 + 2048 + h * 64;
    f32x16 o[2]; o[0] = (f32x16){}; o[1] = (f32x16){};
    float m = -1e30f, l = 0.f;
    ModNA mod; mod.rpb_h = rpb + h * 15 * 31; mod.r = r; mod.c = c; mod.cs = clampi(c - 8, 0, 48); mod.rs = clampi(r - 4, 0, 24); mod.lo = lo; mod.hi = hi;
    attn_loop<64, ModNA>(lds, Kg, Kg + 512, LD0, hirow - lo + 1, qr, o, m, l, mod, tid, lane, r32, hi);
    const float inv = 1.0f / (l + __shfl_xor(l, 32));
    bf16* orow = O + qtok * DM + 512 + h * 64;
    store_o32(orow, o[0] * inv, hi); store_o32(orow + 32, o[1] * inv, hi);
}

__device__ __forceinline__ void diff_unit(LAS unsigned char* lds, const bf16* qkv, bf16* O, float* stash  , const float* subg, float lam, float post, int b, int h, int qb, int tid, int wid, int lane) {
    asm volatile("" : "+v"(tid));
    lane = tid & 63; const int r32 = lane & 31, hi = lane >> 5;
    const int qpos = qb * 256 + wid * 32 + r32;
    const size_t tok0 = (size_t)b * SEQ, qtok = tok0 + qpos;
    ModAlibi mod; mod.slope = __builtin_amdgcn_exp2f(-2.0f * (float)(h + 1)) * L2E; mod.qpos = qpos; mod.hi = hi;
    const bf16* Vg = qkv + tok0 * LD0 + 1024 + h * 128;
#pragma unroll 1
    for (int c = 0; c < 2; ++c) {
        bf16x8 qr[4]; load_q(qr, qkv + qtok * LD0 + h * 128 + c * 64, hi);
        const bf16* Kg = qkv + tok0 * LD0 + 512 + h * 128 + c * 64;
        f32x16 o[4];
#pragma unroll
        for (int db = 0; db < 4; ++db) o[db] = (f32x16){};
        float m = -1e30f, l = 0.f;
        attn_loop<128, ModAlibi>(lds, Kg, Vg, LD0, SEQ / 64, qr, o, m, l, mod, tid, lane, r32, hi);
        const float coef = (c == 0 ? 1.0f : -lam) / (l + __shfl_xor(l, 32));
        f32x4* st = (f32x4*)(stash + (size_t)tid * 64);
        if (c == 0) {
#pragma unroll
            for (int db = 0; db < 4; ++db)
#pragma unroll
                for (int g = 0; g < 4; ++g) st[db * 4 + g] = (f32x4){o[db][4 * g], o[db][4 * g + 1], o[db][4 * g + 2], o[db][4 * g + 3]} * coef;
        } else {
            float ss = 0.f;
#pragma unroll
            for (int db = 0; db < 4; ++db)
#pragma unroll
                for (int g = 0; g < 4; ++g) { const f32x4 p = st[db * 4 + g];
#pragma unroll
                    for (int e = 0; e < 4; ++e) { o[db][4 * g + e] = p[e] + o[db][4 * g + e] * coef; ss += o[db][4 * g + e] * o[db][4 * g + e]; } }
            ss += __shfl_xor(ss, 32);
            const float rstd = post / sqrtf(ss * (1.0f / 128.0f) + EPS);
            bf16* orow = O + qtok * DM + h * 128;
#pragma unroll
            for (int db = 0; db < 4; ++db) {
                f32x16 v = o[db];
#pragma unroll
                for (int g = 0; g < 4; ++g) { const f32x4 gg = *(const f32x4*)(subg + 32 * db + 8 * g + 4 * hi);
                    v[4 * g] *= rstd * gg.x; v[4 * g + 1] *= rstd * gg.y; v[4 * g + 2] *= rstd * gg.z; v[4 * g + 3] *= rstd * gg.w; }
                store_o32(orow + 32 * db, v, hi);
            }
        }
    }
}

__global__ void __launch_bounds__(NTHREADS, 2) trunk_fwd(Args a) {
    extern __shared__ __attribute__((aligned(16))) unsigned char lds_raw[];
    LAS unsigned char* lds = (LAS unsigned char*)lds_raw;
#define G (kargs()->grid)
#define bid (opaque_bid())
#define gw (bid * NWAVES + wave)
#define ngw (G * NWAVES)
#define X (kargs()->out)
#define XN ((bf16*)(WSP + WS_XN))
#define BIG ((bf16*)(WSP + WS_BIG))

    for (int ph = kargs()->lo; ph < kargs()->hi; ++ph) {
        int tid_ = threadIdx.x; asm volatile("" : "+v"(tid_));
        const int tid = tid_, lane = tid & 63, wave = __builtin_amdgcn_readfirstlane(tid >> 6);
        if (ph == 0) {
            convert_weights(a, lds, gw, ngw, wave, lane);
            norm_phase(inp(a, 0), inp(a, 1), inp(a, 2), nullptr, X, XN, 1, gw, ngw, lane);
        } else {
            const int L = (ph - 1) / 11, s = (ph - 1) % 11;
            if (s == 0 || s == 8) {
                const int i = 2 * L + (s == 8);
                pg8::Gemm g{XN, (const bf16*)(WSP + WS_FFN + (size_t)i * SZ_FFN), NTOK, 2 * DFF, DM};
                pg8::StaticOrder S; S.init(NTOK, 2 * DFF, G, bid);
                pg8::EpiSwiglu E{BIG, DFF};
#ifndef NO_SWIGLU
                pg8::gemm_phase<pg8::EpiSwiglu, pg8::StaticOrder, true, true>(lds, g, S, E);
#endif
            } else if (s == 1 || s == 9) {
                const int i = 2 * L + (s == 9);
                pg8::Gemm g{BIG, (const bf16*)(WSP + WS_FFN + (size_t)i * SZ_FFN + SZ_GU), NTOK, DM, DFF};
                pg8::StaticOrder S; S.init(NTOK, DM, G, bid);
                pg8::EpiRes E{X, DM, 0.5f};
#ifndef NO_RES
                pg8::gemm_phase<pg8::EpiRes, pg8::StaticOrder, true, true>(lds, g, S, E);
#endif
            } else if (s == 6) {
                pg8::Gemm g{XN, (const bf16*)(WSP + (L == 0 ? WS_ABOUT : WS_COUT)), NTOK, DM, DM};
                pg8::StaticOrder S; S.init(NTOK, DM, G, bid);
                pg8::EpiRes E{X, DM, 1.0f};
#ifndef NO_RES2
                pg8::gemm_phase<pg8::EpiRes, pg8::StaticOrder, true, true>(lds, g, S, E);
#endif
            } else if (s == 3 && L == 0) {
                pg8::Gemm g{XN, (const bf16*)(WSP + WS_ABIN), NTOK, LD0, DM};
                pg8::StaticOrder S; S.init(NTOK, LD0, G, bid);
                pg8::EpiBf16<0> E{BIG, LD0, nullptr, 0, 0, 1.0f};
#ifndef NO_QKV
                pg8::gemm_phase<pg8::EpiBf16<0>, pg8::StaticOrder, true, true>(lds, g, S, E);
#endif
            } else if (s == 3) {
                pg8::Gemm g{XN, (const bf16*)(WSP + WS_CIN), NTOK, LD1, DM};
                pg8::StaticOrder S; S.init(NTOK, LD1, G, bid);
                pg8::EpiBf16<0> E{BIG, LD1, nullptr, 0, 0, 1.0f};
#ifndef NO_QKV2
                pg8::gemm_phase<pg8::EpiBf16<0>, pg8::StaticOrder, true, true>(lds, g, S, E);
#endif
            } else if (s == 2) {
                norm_phase(X, nullptr, inp(a, 6) + L * DM, nullptr, nullptr, XN, 0, gw, ngw, lane);
            } else if (s == 7) {
                norm_phase(X, nullptr, inp(a, 23) + L * DM, nullptr, nullptr, XN, 0, gw, ngw, lane);
            } else if (s == 10) {
                if (L == 0) norm_phase(X, nullptr, inp(a, 27), inp(a, 2) + DM, X, XN, 2, gw, ngw, lane);
                else        norm_phase(X, nullptr, inp(a, 27) + DM, nullptr, X, nullptr, 3, gw, ngw, lane);
            } else if (s == 4) {
                qknorm_phase(a, L, BIG, bid * NTHREADS + tid, G * NTHREADS, lane);
            } else {
                if (L == 0) {
                    const float d1 = wave_sum(inp(a, 11)[lane] * inp(a, 12)[lane]), d2 = wave_sum(inp(a, 13)[lane] * inp(a, 14)[lane]);
                    const float lambda_init = 0.2f;
                    const float lam = __expf(d1) - __expf(d2) + lambda_init;
                    for (int u = bid; u < 1536 + 3072; u += G) {
                        if (u < 1536) {
#ifndef NO_DIFF
 diff_unit(lds, BIG, XN, (float*)(WSP + WS_STASH) + (size_t)bid * 64 * NTHREADS, inp(a, 15), lam, 1.0f - lambda_init, u >> 5, (u >> 3) & 3, u & 7, tid, wave, lane);
#endif
 }
                        else { const int v = u - 1536;
#ifndef NO_NA
 na_unit(lds, BIG, XN, inp(a, 18), v >> 6, (v >> 3) & 7, v & 7, tid, wave, lane);
#endif
 }
                    }
                } else {
                    for (int u = bid; u < NBATCH * 16 * 8; u += G) {
#ifndef NO_GQA
 gqa_unit(lds, BIG, XN, u >> 7, (u >> 3) & 15, u & 7, tid, wave, lane);
#endif
 }
                }
            }
        }
        if (ph + 1 < kargs()->hi) cg::this_grid().sync();
    }
}

#undef G
#undef bid
#undef gw
#undef ngw
#undef X
#undef XN
#undef BIG
#ifndef N_LAUNCH_MODE
#define N_LAUNCH_MODE 0
#endif
extern "C" void kernel_launch(void* const* d_in, const int* in_sizes, int n_in, void* d_out, int out_size, void* d_ws, size_t ws_size, hipStream_t stream) {
    static int grid = 0;
    if (grid == 0) {
        if (n_in != 28 || out_size != NTOK * DM || ws_size < WS_END) { fprintf(stderr, "kernel_launch: unexpected shapes (n_in %d out %d ws %zu)\n", n_in, out_size, ws_size); grid = -1; return; }
        int dev = 0, cus = 0, per_cu = 0;
        if (hipGetDevice(&dev) != hipSuccess || hipDeviceGetAttribute(&cus, hipDeviceAttributeMultiprocessorCount, dev) != hipSuccess) { grid = -1; return; }
        if (hipFuncSetAttribute((const void*)trunk_fwd, hipFuncAttributeMaxDynamicSharedMemorySize, LDS_BYTES) != hipSuccess) { fprintf(stderr, "kernel_launch: hipFuncSetAttribute failed\n"); grid = -1; return; }
        if (hipOccupancyMaxActiveBlocksPerMultiprocessor(&per_cu, (const void*)trunk_fwd, NTHREADS, LDS_BYTES) != hipSuccess || per_cu < 1) { fprintf(stderr, "kernel_launch: occupancy query says %d\n", per_cu); per_cu = 1; }
        (void)hipGetLastError();
        grid = cus * 1;
    }
    if (grid < 0) return;
    Args a{};
    for (int i = 0; i < 28; ++i) a.in[i] = (const float*)d_in[i];
    a.out = (float*)d_out; a.ws = (unsigned char*)d_ws; a.grid = grid;
#if N_LAUNCH_MODE == 1
    for (int ph = 0; ph < NPHASES; ++ph) { a.lo = ph; a.hi = ph + 1; hipLaunchKernelGGL(trunk_fwd, dim3(grid), dim3(NTHREADS), LDS_BYTES, stream, a); }
#else
    a.lo = 0; a.hi = NPHASES;
    void* args[] = {&a};
    hipError_t e = hipLaunchCooperativeKernel((const void*)trunk_fwd, dim3(grid), dim3(NTHREADS), args, LDS_BYTES, stream);
    if (e != hipSuccess) fprintf(stderr, "kernel_launch: cooperative launch failed: %s (grid %d)\n", hipGetErrorString(e), grid);
#endif
}
```

```cpp
#include <hip/hip_runtime.h>
#include <cstdio>
#include <cstdint>
#include <cmath>
namespace pg8 {
#define PG8_LAS __attribute__((address_space(3)))
typedef unsigned short bf16_t;
typedef short bf16x8 __attribute__((ext_vector_type(8)));
typedef float f32x4 __attribute__((ext_vector_type(4)));
typedef unsigned u32x4 __attribute__((ext_vector_type(4)));
constexpr int BM = 256, BK = 64, HALF = 128, HTB = HALF * BK * 2  , STAGE_BYTES = 8 * HTB, NXCD = 8, WGM = 8;

__host__ __device__ __forceinline__ int lds_byte(int r, int c) { const int st = (r >> 4) * 2 + (c >> 5), rr = r & 15, cc = c & 31, ob = rr * 64 + cc * 2; return st * 1024 + (ob ^ (((ob >> 9) & 1) << 5)); }
__host__ __device__ __forceinline__ void stage_rc(int b, int& R, int& C) { const int st = b / 1024, sb = b % 1024, swz = sb ^ (((sb >> 9) & 1) << 5); R = (st >> 1) * 16 + swz / 64; C = (st & 1) * 32 + (swz % 64) / 2; }
__host__ __device__ __forceinline__ int perm32(int rho) { const int n = rho >> 4, i = rho & 15; return 8 * (i >> 2) + 4 * n + (i & 3); }

struct Unit { int pm, pn; };
struct Gemm { const bf16_t* A; const bf16_t* Bt; int M, N, K; };

struct StaticOrder {
    int nM, nN, nwg, G, c;
    __host__ __device__ void init(int M, int N, int G_, int c_) { nM = M / BM; nN = N / BM; nwg = nM * nN; G = G_; c = c_; }
    __host__ __device__ bool next(int i, Unit& u) const {
        const long L = (long)i * G + c; if (L >= nwg) return false;
        int wgid = (int)L; { const int q = nwg / NXCD, r = nwg % NXCD, xcd = wgid % NXCD, off = wgid / NXCD; wgid = (xcd < r ? xcd * (q + 1) : r * (q + 1) + (xcd - r) * q) + off; }
        const int nig = WGM * nN, gid = wgid / nig, fm = gid * WGM, gsz = (nM - fm) < WGM ? (nM - fm) : WGM;
        u.pm = fm + ((wgid % nig) % gsz); u.pn = (wgid % nig) / gsz; return true;
    }
    __device__ __forceinline__ void a_ready(const Unit&) const {}
    __device__ __forceinline__ void done(const Unit&) const {}
};

__device__ __forceinline__ unsigned cvt_pk_bf16(float lo, float hi) { unsigned r; asm volatile("v_cvt_pk_bf16_f32 %0, %1, %2" : "=v"(r) : "v"(lo), "v"(hi)); return r; }
typedef float f32x2 __attribute__((ext_vector_type(2)));
__device__ __forceinline__ f32x2 gelu_pk(f32x2 v) {
    const f32x2 av = __builtin_elementwise_abs(v), d = av * 0.2316418882f + 1.0f;
    f32x2 t; t.x = __builtin_amdgcn_rcpf(d.x); t.y = __builtin_amdgcn_rcpf(d.y);
    f32x2 q = t * 0.5307027145f + (-0.7265760135f); q = q * t + 0.7107068705f; q = q * t + (-0.142248368f); q = q * t + 0.127414796f; q = q * t;
    const f32x2 s = (v * v) * (-0.72134752044f);
    f32x2 e; e.x = __builtin_amdgcn_exp2f(s.x); e.y = __builtin_amdgcn_exp2f(s.y);
    const f32x2 m = v * (q * e), r = v - m;
    f32x2 o; o.x = v.x < 0.f ? m.x : r.x; o.y = v.y < 0.f ? m.y : r.y; return o;
}

template <int ACT  > struct EpiBf16 {
    static constexpr bool PERM = true, AFTER_DRAIN = false; static_assert(ACT == 0 || ACT == 1, "EpiBf16: ACT is 0 (none) or 1 (gelu_pk)");
    bf16_t* O; int ldc; const float* bias; int split_cols; size_t split_stride; float scale0;
    __device__ __forceinline__ void operator()(const f32x4 (&acc)[2][2][4][2], const Unit& u, int wr, int wc, int fr, int fq) const {
        const int row0 = u.pm * BM + wr * 64 + fr; int colt = u.pn * BM; bf16_t* base = O;
        float sc = 1.f; if (split_cols) { const int t = colt / split_cols; base += (size_t)t * split_stride; colt -= t * split_cols; if (t == 0) sc = scale0; }
        const int col0 = colt + wc * 32 + 8 * fq, bcol0 = u.pn * BM + wc * 32 + 8 * fq;
        f32x4 bv[2][2];
#pragma unroll
        for (int bj = 0; bj < 2; ++bj)
#pragma unroll
            for (int n = 0; n < 2; ++n) bv[bj][n] = bias ? *(const f32x4*)(bias + bcol0 + bj * HALF + 4 * n) : (f32x4){0.f, 0.f, 0.f, 0.f};
#pragma unroll
        for (int ai = 0; ai < 2; ++ai)
#pragma unroll
            for (int m = 0; m < 4; ++m) { bf16_t* rowp = base + (size_t)(row0 + ai * HALF + m * 16) * ldc + col0;
#pragma unroll
                for (int bj = 0; bj < 2; ++bj) { f32x4 v0 = acc[ai][bj][m][0] + bv[bj][0], v1 = acc[ai][bj][m][1] + bv[bj][1];
                    if (ACT == 1) { f32x2 a = gelu_pk((f32x2){v0[0], v0[1]}), b = gelu_pk((f32x2){v0[2], v0[3]}), c = gelu_pk((f32x2){v1[0], v1[1]}), d = gelu_pk((f32x2){v1[2], v1[3]});
                        v0 = (f32x4){a.x, a.y, b.x, b.y}; v1 = (f32x4){c.x, c.y, d.x, d.y}; }
                    v0 = v0 * sc; v1 = v1 * sc; u32x4 w; w.x = cvt_pk_bf16(v0[0], v0[1]); w.y = cvt_pk_bf16(v0[2], v0[3]); w.z = cvt_pk_bf16(v1[0], v1[1]); w.w = cvt_pk_bf16(v1[2], v1[3]);
                    *(u32x4*)(rowp + bj * HALF) = w; } }
    }
};

struct EpiSwiglu {
    static constexpr bool PERM = true, AFTER_DRAIN = false;
    bf16_t* H; int ldh;
    __device__ __forceinline__ void operator()(const f32x4 (&acc)[2][2][4][2], const Unit& u, int wr, int wc, int fr, int fq) const {
        const int row0 = u.pm * BM + wr * 64 + fr; const int col0 = u.pn * HALF + wc * 32 + 8 * fq;
#pragma unroll
        for (int ai = 0; ai < 2; ++ai)
#pragma unroll
            for (int m = 0; m < 4; ++m) { bf16_t* rowp = H + (size_t)(row0 + ai * HALF + m * 16) * ldh + col0;
                float hv[8];
#pragma unroll
                for (int n = 0; n < 2; ++n)
#pragma unroll
                    for (int e = 0; e < 4; ++e) { const float g = acc[ai][0][m][n][e], up = acc[ai][1][m][n][e];
                        const float sg = __builtin_amdgcn_rcpf(1.0f + __builtin_amdgcn_exp2f(-1.4426950408889634f * g));
                        hv[n * 4 + e] = g * sg * up; }
                u32x4 w; w.x = cvt_pk_bf16(hv[0], hv[1]); w.y = cvt_pk_bf16(hv[2], hv[3]); w.z = cvt_pk_bf16(hv[4], hv[5]); w.w = cvt_pk_bf16(hv[6], hv[7]);
                *(u32x4*)rowp = w; }
    }
};
struct EpiRes {
    static constexpr bool PERM = true, AFTER_DRAIN = false;
    float* X; int ldc; float alpha;
    __device__ __forceinline__ void operator()(const f32x4 (&acc)[2][2][4][2], const Unit& u, int wr, int wc, int fr, int fq) const {
        const int row0 = u.pm * BM + wr * 64 + fr; const int col0 = u.pn * BM + wc * 32 + 8 * fq;
#pragma unroll
        for (int ai = 0; ai < 2; ++ai)
#pragma unroll
            for (int m = 0; m < 4; ++m) { float* rowp = X + (size_t)(row0 + ai * HALF + m * 16) * ldc + col0;
#pragma unroll
                for (int bj = 0; bj < 2; ++bj) { f32x4 a = *(const f32x4*)(rowp + bj * HALF), b = *(const f32x4*)(rowp + bj * HALF + 4);
                    a += acc[ai][bj][m][0] * alpha; b += acc[ai][bj][m][1] * alpha;
                    *(f32x4*)(rowp + bj * HALF) = a; *(f32x4*)(rowp + bj * HALF + 4) = b; } }
    }
};

__device__ __forceinline__ float row_rstd(const float* Sa, const float* Sb, int row) {
    float r = 1.0f / sqrtf(Sa[row] * (1.0f / 1024.0f) + 1e-6f);
    if (Sb) r *= 1.0f / sqrtf(r * r * Sb[row] * (1.0f / 1024.0f) + 1e-6f);
    return r;
}
struct EpiSwiglu2 {
    static constexpr bool PERM = true, AFTER_DRAIN = false;
    bf16_t* H; int ldh; const float* Sa; const float* Sb;
    __device__ __forceinline__ void operator()(const f32x4 (&acc)[2][2][4][2], const Unit& u, int wr, int wc, int fr, int fq) const {
        const int row0 = u.pm * BM + wr * 64 + fr; const int col0 = u.pn * HALF + wc * 32 + 8 * fq;
#pragma unroll
        for (int ai = 0; ai < 2; ++ai)
#pragma unroll
            for (int m = 0; m < 4; ++m) { const int row = row0 + ai * HALF + m * 16; bf16_t* rowp = H + (size_t)row * ldh + col0;
                const float rs = row_rstd(Sa, Sb, row);
                float hv[8];
#pragma unroll
                for (int n = 0; n < 2; ++n)
#pragma unroll
                    for (int e = 0; e < 4; ++e) { const float g = acc[ai][0][m][n][e] * rs, up = acc[ai][1][m][n][e] * rs;
                        const float sg = __builtin_amdgcn_rcpf(1.0f + __builtin_amdgcn_exp2f(-1.4426950408889634f * g));
                        hv[n * 4 + e] = g * sg * up; }
                u32x4 w; w.x = cvt_pk_bf16(hv[0], hv[1]); w.y = cvt_pk_bf16(hv[2], hv[3]); w.z = cvt_pk_bf16(hv[4], hv[5]); w.w = cvt_pk_bf16(hv[6], hv[7]);
                *(u32x4*)rowp = w; }
    }
};
struct EpiRow {
    static constexpr bool PERM = true, AFTER_DRAIN = false;
    bf16_t* O; int ldc; const float* Sa;
    __device__ __forceinline__ void operator()(const f32x4 (&acc)[2][2][4][2], const Unit& u, int wr, int wc, int fr, int fq) const {
        const int row0 = u.pm * BM + wr * 64 + fr; const int col0 = u.pn * BM + wc * 32 + 8 * fq;
#pragma unroll
        for (int ai = 0; ai < 2; ++ai)
#pragma unroll
            for (int m = 0; m < 4; ++m) { const int row = row0 + ai * HALF + m * 16; bf16_t* rowp = O + (size_t)row * ldc + col0;
                const float rs = row_rstd(Sa, nullptr, row);
#pragma unroll
                for (int bj = 0; bj < 2; ++bj) { const f32x4 v0 = acc[ai][bj][m][0] * rs, v1 = acc[ai][bj][m][1] * rs;
                    u32x4 w; w.x = cvt_pk_bf16(v0[0], v0[1]); w.y = cvt_pk_bf16(v0[2], v0[3]); w.z = cvt_pk_bf16(v1[0], v1[1]); w.w = cvt_pk_bf16(v1[2], v1[3]);
                    *(u32x4*)(rowp + bj * HALF) = w; } }
    }
};
struct EpiRes2 {
    static constexpr bool PERM = true, AFTER_DRAIN = false;
    float* xr; bf16_t* xb; float* S1; float* S2; const float* Sin; const float* gin; const float* gout; float alpha;
    __device__ __forceinline__ void operator()(const f32x4 (&acc)[2][2][4][2], const Unit& u, int wr, int wc, int fr, int fq) const {
        const int row0 = u.pm * BM + wr * 64 + fr; const int col0 = u.pn * BM + wc * 32 + 8 * fq;
        f32x4 gi[2][2], go[2][2];
#pragma unroll
        for (int bj = 0; bj < 2; ++bj)
#pragma unroll
            for (int n = 0; n < 2; ++n) { gi[bj][n] = gin ? *(const f32x4*)(gin + col0 + bj * HALF + 4 * n) : (f32x4){1.f, 1.f, 1.f, 1.f};
                                          go[bj][n] = gout ? *(const f32x4*)(gout + col0 + bj * HALF + 4 * n) : (f32x4){1.f, 1.f, 1.f, 1.f}; }
#pragma unroll
        for (int ai = 0; ai < 2; ++ai)
#pragma unroll
            for (int m = 0; m < 4; ++m) { const int row = row0 + ai * HALF + m * 16; float* rowp = xr + (size_t)row * 1024 + col0;
                const float rsc = gin ? 1.0f / sqrtf(Sin[row] * (1.0f / 1024.0f) + 1e-6f) : 1.0f;
                float s1 = 0.f, s2 = 0.f;
#pragma unroll
                for (int bj = 0; bj < 2; ++bj) { f32x4 a = *(const f32x4*)(rowp + bj * HALF), b = *(const f32x4*)(rowp + bj * HALF + 4);
                    a = a * (gi[bj][0] * rsc) + acc[ai][bj][m][0] * alpha; b = b * (gi[bj][1] * rsc) + acc[ai][bj][m][1] * alpha;
                    *(f32x4*)(rowp + bj * HALF) = a; *(f32x4*)(rowp + bj * HALF + 4) = b;
                    s1 += (a[0] * a[0] + a[1] * a[1]) + (a[2] * a[2] + a[3] * a[3]) + (b[0] * b[0] + b[1] * b[1]) + (b[2] * b[2] + b[3] * b[3]);
                    a = a * go[bj][0]; b = b * go[bj][1];
                    s2 += (a[0] * a[0] + a[1] * a[1]) + (a[2] * a[2] + a[3] * a[3]) + (b[0] * b[0] + b[1] * b[1]) + (b[2] * b[2] + b[3] * b[3]);
                    if (xb) { u32x4 w; w.x = cvt_pk_bf16(a[0], a[1]); w.y = cvt_pk_bf16(a[2], a[3]); w.z = cvt_pk_bf16(b[0], b[1]); w.w = cvt_pk_bf16(b[2], b[3]);
                        *(u32x4*)(xb + (size_t)row * 1024 + col0 + bj * HALF) = w; } }
                s1 += __shfl_xor(s1, 16); s1 += __shfl_xor(s1, 32); s2 += __shfl_xor(s2, 16); s2 += __shfl_xor(s2, 32);
                if (fq == 0) { __hip_atomic_fetch_add(S1 + row, s1, __ATOMIC_RELAXED, __HIP_MEMORY_SCOPE_AGENT);
                               if (S2) __hip_atomic_fetch_add(S2 + row, s2, __ATOMIC_RELAXED, __HIP_MEMORY_SCOPE_AGENT); } }
    }
};
template <class Epi, class Sched, bool ALIGN_EPI = false, bool SP2 = false>
__device__ __forceinline__ void gemm_phase(PG8_LAS unsigned char* lds, const Gemm g, const Sched& S, const Epi& E) {
    int tid_ = threadIdx.x; asm volatile("" : "+v"(tid_));
    const int tid = tid_, wid = __builtin_amdgcn_readfirstlane(tid >> 6), lane = tid & 63, wr = wid >> 2, wc = wid & 3, fr = lane & 15, fq = lane >> 4;
    const int K = g.K, nt = K / BK;
    unsigned voffA[2], voffB[2];
#pragma unroll
    for (int i = 0; i < 2; ++i) { int R, C; stage_rc(tid * 16 + i * 8192, R, C); const int Rb = Epi::PERM ? ((R & ~31) + perm32(R & 31)) : R;
        voffA[i] = (unsigned)(R * K + C) * 2u; voffB[i] = (unsigned)(Rb * K + C) * 2u; }
    const size_t kstep = (size_t)(BK * 2);
    const size_t hstep = (size_t)HALF * K * 2;
    const size_t tstep = 2 * hstep;
    const unsigned ldsw = (unsigned)wid * 1024u;
    const int aoff = lds_byte(wr * 64 + fr, fq * 8), boff = lds_byte(wc * 32 + fr, fq * 8);
#define PG8_SA(b, h) (((b) * 2 + (h)) * HTB)
#define PG8_SB(b, h) ((4 + (b) * 2 + (h)) * HTB)
#define PG8_STAGE(bufoff, gbase, voff) do { _Pragma("unroll") for (int _i = 0; _i < 2; ++_i) \
        __builtin_amdgcn_global_load_lds((const unsigned*)((const char*)(gbase) + (voff)[_i]), (PG8_LAS unsigned*)(lds + (bufoff) + ldsw + _i * 8192), 16, 0, 0); } while (0)
#define PG8_LDA(dst, b, h) do { _Pragma("unroll") for (int m = 0; m < 4; ++m) _Pragma("unroll") for (int k = 0; k < 2; ++k) dst[m][k] = *(const PG8_LAS bf16x8*)(lds + PG8_SA(b, h) + aoff + m * 2048 + k * 1024); } while (0)
#define PG8_LDB(dst, b, h) do { _Pragma("unroll") for (int n = 0; n < 2; ++n) _Pragma("unroll") for (int k = 0; k < 2; ++k) dst[n][k] = *(const PG8_LAS bf16x8*)(lds + PG8_SB(b, h) + boff + n * 2048 + k * 1024); } while (0)
#define PG8_MMA(ai, bj, At, Bt) do { __builtin_amdgcn_s_setprio(1); _Pragma("unroll") for (int m = 0; m < 4; ++m) _Pragma("unroll") for (int n = 0; n < 2; ++n) _Pragma("unroll") for (int k = 0; k < 2; ++k) \
        acc[ai][bj][m][n] = __builtin_amdgcn_mfma_f32_16x16x32_bf16(Bt[n][k], At[m][k], acc[ai][bj][m][n], 0, 0, 0); __builtin_amdgcn_s_setprio(0); } while (0)
#define PG8_WAIT_V(n) asm volatile("s_waitcnt vmcnt(" #n ")" ::: "memory")
#define PG8_WAIT_L(n) asm volatile("s_waitcnt lgkmcnt(" #n ")" ::: "memory")
#define PG8_BAR __builtin_amdgcn_s_barrier()
#define PG8_SCHED __builtin_amdgcn_sched_barrier(0)
    Unit cur, nxt; int ui = 0;
    if (!S.next(0, cur)) return;
    f32x4 acc[2][2][4][2];
#pragma unroll
    for (int a = 0; a < 2; ++a)
#pragma unroll
        for (int b = 0; b < 2; ++b)
#pragma unroll
            for (int m = 0; m < 4; ++m)
#pragma unroll
                for (int n = 0; n < 2; ++n) acc[a][b][m][n] = (f32x4){0.f, 0.f, 0.f, 0.f};
    bf16x8 At[4][2], B0[2][2], B1[2][2];
    const char* cA = (const char*)g.A + (size_t)cur.pm * tstep; const char* cB = (const char*)g.Bt + (size_t)cur.pn * tstep;
    S.a_ready(cur);
    if constexpr (SP2) {
        PG8_STAGE(PG8_SB(0, 0), cB, voffB); PG8_STAGE(PG8_SB(0, 1), cB + hstep, voffB); PG8_STAGE(PG8_SA(0, 0), cA, voffA); PG8_STAGE(PG8_SA(0, 1), cA + hstep, voffA);
        if (wr == 1) PG8_BAR;
        PG8_WAIT_V(2); PG8_BAR;
        PG8_STAGE(PG8_SB(1, 0), cB + kstep, voffB); PG8_STAGE(PG8_SA(1, 0), cA + kstep, voffA); PG8_STAGE(PG8_SB(1, 1), cB + hstep + kstep, voffB);
        PG8_WAIT_V(6); PG8_BAR;
    } else {
        PG8_STAGE(PG8_SB(0, 0), cB, voffB); PG8_STAGE(PG8_SA(0, 0), cA, voffA); PG8_STAGE(PG8_SB(0, 1), cB + hstep, voffB); PG8_STAGE(PG8_SA(0, 1), cA + hstep, voffA);
        if (wr == 1) PG8_BAR;
        PG8_WAIT_V(4); PG8_BAR;
        PG8_STAGE(PG8_SB(1, 0), cB + kstep, voffB); PG8_STAGE(PG8_SA(1, 0), cA + kstep, voffA); PG8_STAGE(PG8_SB(1, 1), cB + hstep + kstep, voffB);
        PG8_WAIT_V(6); PG8_BAR;
    }
    for (;;) {
        const bool has_next = S.next(ui + 1, nxt);
        const char* nA = has_next ? (const char*)g.A + (size_t)nxt.pm * tstep : cA; const char* nB = has_next ? (const char*)g.Bt + (size_t)nxt.pn * tstep : cB;
        for (int t = 0; t < nt; t += 2) {
            const bool last = (t == nt - 2);
            const char* a1 = cA + (size_t)(t + 1) * kstep;
            const char* a2 = last ? nA : cA + (size_t)(t + 2) * kstep; const char* b2 = last ? nB : cB + (size_t)(t + 2) * kstep;
            const char* a3 = a2 + kstep; const char* b3 = b2 + kstep;
            if (last && has_next) S.a_ready(nxt);
            if constexpr (SP2) {
            PG8_LDB(B0, 0, 0); PG8_LDB(B1, 0, 1); PG8_SCHED; PG8_LDA(At, 0, 0); PG8_STAGE(PG8_SA(1, 1), a1 + hstep, voffA);
            PG8_WAIT_V(8); PG8_WAIT_L(0); PG8_BAR; PG8_MMA(0, 0, At, B0); PG8_MMA(0, 1, At, B1); PG8_BAR; PG8_SCHED;
            PG8_LDA(At, 0, 1); PG8_STAGE(PG8_SB(0, 0), b2, voffB); PG8_STAGE(PG8_SB(0, 1), b2 + hstep, voffB); PG8_STAGE(PG8_SA(0, 0), a2, voffA);
            PG8_WAIT_V(8); PG8_WAIT_L(0); PG8_BAR; PG8_MMA(1, 0, At, B0); PG8_MMA(1, 1, At, B1); PG8_BAR; PG8_SCHED;
            PG8_LDB(B0, 1, 0); PG8_LDB(B1, 1, 1); PG8_SCHED; PG8_LDA(At, 1, 0); PG8_STAGE(PG8_SA(0, 1), a2 + hstep, voffA);
            PG8_WAIT_V(8); PG8_WAIT_L(0); PG8_BAR; PG8_MMA(0, 0, At, B0); PG8_MMA(0, 1, At, B1); PG8_BAR; PG8_SCHED;
            PG8_LDA(At, 1, 1); PG8_STAGE(PG8_SB(1, 0), b3, voffB); PG8_STAGE(PG8_SB(1, 1), b3 + hstep, voffB); PG8_STAGE(PG8_SA(1, 0), a3, voffA);
            PG8_WAIT_V(8); PG8_WAIT_L(0); PG8_BAR; PG8_MMA(1, 0, At, B0); PG8_MMA(1, 1, At, B1); PG8_BAR; PG8_SCHED;
            } else {
            PG8_LDB(B0, 0, 0); PG8_SCHED; PG8_LDA(At, 0, 0); PG8_STAGE(PG8_SA(1, 1), a1 + hstep, voffA);
            PG8_WAIT_L(8); PG8_BAR; PG8_WAIT_L(0); PG8_MMA(0, 0, At, B0); PG8_BAR; PG8_SCHED;
            PG8_LDB(B1, 0, 1); PG8_STAGE(PG8_SB(0, 0), b2, voffB);
            PG8_BAR; PG8_WAIT_L(0); PG8_MMA(0, 1, At, B1); PG8_BAR;
            PG8_LDA(At, 0, 1); PG8_STAGE(PG8_SA(0, 0), a2, voffA);
            PG8_BAR; PG8_WAIT_L(0); PG8_MMA(1, 0, At, B0); PG8_BAR; PG8_SCHED;
            PG8_STAGE(PG8_SB(0, 1), b2 + hstep, voffB);
            PG8_WAIT_V(6); PG8_BAR; PG8_MMA(1, 1, At, B1); PG8_BAR;
            PG8_LDB(B0, 1, 0); PG8_SCHED; PG8_LDA(At, 1, 0); PG8_STAGE(PG8_SA(0, 1), a2 + hstep, voffA);
            PG8_WAIT_L(8); PG8_BAR; PG8_WAIT_L(0); PG8_MMA(0, 0, At, B0); PG8_BAR; PG8_SCHED;
            PG8_LDB(B1, 1, 1); PG8_STAGE(PG8_SB(1, 0), b3, voffB);
            PG8_BAR; PG8_WAIT_L(0); PG8_MMA(0, 1, At, B1); PG8_BAR;
            PG8_LDA(At, 1, 1); PG8_STAGE(PG8_SA(1, 0), a3, voffA);
            PG8_BAR; PG8_WAIT_L(0); PG8_MMA(1, 0, At, B0); PG8_BAR; PG8_SCHED;
            PG8_STAGE(PG8_SB(1, 1), b3 + hstep, voffB);
            PG8_WAIT_V(6); PG8_BAR; PG8_MMA(1, 1, At, B1); PG8_BAR;
            }
        }
        if constexpr (ALIGN_EPI) { if (wr == 0) PG8_BAR; }
        if constexpr (!Epi::AFTER_DRAIN) { E(acc, cur, wr, wc, fr, fq); S.done(cur); }
        if (!has_next) break;
#pragma unroll
        for (int a = 0; a < 2; ++a)
#pragma unroll
            for (int b = 0; b < 2; ++b)
#pragma unroll
                for (int m = 0; m < 4; ++m)
#pragma unroll
                    for (int n = 0; n < 2; ++n) acc[a][b][m][n] = (f32x4){0.f, 0.f, 0.f, 0.f};
        cur = nxt; cA = nA; cB = nB; ++ui;
        if constexpr (ALIGN_EPI) { if (wr == 1) PG8_BAR; }
    }
    PG8_WAIT_V(0);
    if constexpr (!ALIGN_EPI) { if (wr == 0) PG8_BAR; }
    PG8_BAR;
    if constexpr (Epi::AFTER_DRAIN) { E.fused(acc, cur, wr, wc, fr, fq, lds, wid, lane); S.done(cur); }
#undef PG8_SA
#undef PG8_SB
#undef PG8_STAGE
#undef PG8_LDA
#undef PG8_LDB
#undef PG8_MMA
#undef PG8_WAIT_V
#undef PG8_WAIT_L
#undef PG8_BAR
#undef PG8_SCHED
}
}
#define N_LAUNCH_MODE 0

#include <hip/hip_cooperative_groups.h>
namespace cg = cooperative_groups;

#define LAS __attribute__((address_space(3)))
typedef unsigned short bf16;
typedef float f32x4 __attribute__((ext_vector_type(4)));
typedef float f32x16 __attribute__((ext_vector_type(16)));
typedef short bf16x8 __attribute__((ext_vector_type(8)));
typedef short s16x4 __attribute__((ext_vector_type(4)));
typedef short v4i16_t __attribute__((ext_vector_type(4)));
typedef unsigned u32x4 __attribute__((ext_vector_type(4)));
typedef unsigned u32x2 __attribute__((ext_vector_type(2)));
typedef float f32x2_t __attribute__((ext_vector_type(2)));
typedef __bf16 bf16x2_t __attribute__((ext_vector_type(2)));

constexpr int NTOK = 98304, NPROMPT = 65536, DM = 1024, DFF = 2816, SEQ = 2048, NBATCH = 48;
constexpr int LD0 = 3072, LD1 = 1536;
constexpr float EPS = 1e-6f, L2E = 1.4426950408889634f;
constexpr float QSCALE = 0.125f * L2E;
constexpr int NWAVES = 8, NTHREADS = 512;
constexpr int LDS_BYTES = 147456;
constexpr int NPHASES = 18;

constexpr size_t MiB = 1u << 20;
constexpr size_t SZ_GU = (size_t)2 * DFF * DM * 2, SZ_D = (size_t)DM * DFF * 2, SZ_FFN = SZ_GU + SZ_D;
constexpr size_t WS_FFN = 0;
constexpr size_t WS_ABIN = 4 * SZ_FFN, WS_ABOUT = WS_ABIN + (size_t)LD0 * DM * 2, WS_CIN = WS_ABOUT + (size_t)DM * DM * 2, WS_COUT = WS_CIN + (size_t)LD1 * DM * 2;
constexpr size_t WS_WEND = WS_COUT + (size_t)DM * DM * 2;
constexpr size_t WS_XN = 96 * MiB;
constexpr size_t WS_BIG = 288 * MiB;
constexpr size_t WS_S = 80 * MiB;
constexpr size_t WS_XB2 = 832 * MiB;
constexpr size_t WS_STASH = 864 * MiB;
constexpr size_t WS_END = 1024 * MiB;
static_assert(WS_WEND <= WS_S && WS_S + 8 * (size_t)NTOK * 4 <= WS_XN && WS_BIG + (size_t)NTOK * DFF * 2 <= WS_XB2 && WS_XB2 + (size_t)NTOK * DM * 2 <= WS_END && WS_STASH + 256 * 64 * 512 * 4 <= WS_END && WS_XN + (size_t)NTOK * DM * 2 <= WS_BIG && WS_BIG + (size_t)NTOK * LD0 * 2 <= WS_END, "d_ws map");

struct Args { const float* in[28]; float* out; unsigned char* ws; int lo, hi, grid, ascale; };
__device__ __forceinline__ int opaque_bid() { int b = blockIdx.x; asm volatile("" : "+s"(b)); return b; }
typedef const __attribute__((address_space(4))) Args* KArgs;
__device__ __forceinline__ KArgs kargs() { KArgs p = (KArgs)__builtin_amdgcn_kernarg_segment_ptr(); asm volatile("" : "+s"(p)); return p; }
#define inp(a_, i_) (kargs()->in[(i_)])
#define WSP (kargs()->ws)

__device__ __forceinline__ float wave_sum(float v) {
#pragma unroll
    for (int o = 1; o < 64; o <<= 1) v += __shfl_xor(v, o);
    return v;
}
__device__ __forceinline__ float wave_max(float v) {
#pragma unroll
    for (int o = 1; o < 64; o <<= 1) v = fmaxf(v, __shfl_xor(v, o));
    return v;
}
__device__ __forceinline__ float uni(float v) { return __builtin_bit_cast(float, __builtin_amdgcn_readfirstlane(__builtin_bit_cast(int, v))); }
__device__ __forceinline__ unsigned cvtpk(float lo, float hi) { f32x2_t v = {lo, hi}; bf16x2_t b = __builtin_convertvector(v, bf16x2_t); return __builtin_bit_cast(unsigned, b); }
__device__ __forceinline__ float bf2f(unsigned short h) { return __uint_as_float((unsigned)h << 16); }
__device__ __forceinline__ int clampi(int v, int lo, int hi) { return v < lo ? lo : (v > hi ? hi : v); }

__device__ __forceinline__ void tr_item(const float* W, int K, int N, bf16* WT, int mode, LAS float* scr, int item, int lane, const float* gk = nullptr) {
    const int nblk = N / 32, kb = item / nblk, nb = item % nblk, k0 = 64 * kb, n0 = 32 * nb;
    const int drow0 = (mode == 0) ? n0 : ((n0 >> 7) * 256 + (n0 & 127) + (mode == 2 ? 128 : 0));
#pragma unroll 8
    for (int i = 0; i < 32; ++i) { const int kk = 2 * i + (lane >> 5); const float gg = gk ? gk[k0 + kk] : 1.0f; scr[kk * 33 + (lane & 31)] = W[(size_t)(k0 + kk) * N + n0 + (lane & 31)] * gg; }
    asm volatile("s_waitcnt lgkmcnt(0)" ::: "memory");
    const int c = lane & 7;
#pragma unroll
    for (int j = 0; j < 4; ++j) { const int n = (lane >> 3) + 8 * j; const LAS float* s = scr + (8 * c) * 33 + n;
        u32x4 o; o.x = cvtpk(s[0 * 33], s[1 * 33]); o.y = cvtpk(s[2 * 33], s[3 * 33]); o.z = cvtpk(s[4 * 33], s[5 * 33]); o.w = cvtpk(s[6 * 33], s[7 * 33]);
        *(u32x4*)(WT + (size_t)(drow0 + n) * K + k0 + 8 * c) = o; }
    asm volatile("s_waitcnt lgkmcnt(0)" ::: "memory");
}

__device__ __forceinline__ void convert_weights(const Args& a, LAS unsigned char* lds, int gw, int ngw, int wave, int lane) {
    LAS float* scr = (LAS float*)(lds + wave * 16384);
    constexpr int I_F = (DM / 64) * (DFF / 32);
    constexpr int I_FFN = 4 * 3 * I_F;
    constexpr int I_ABIN = (DM / 64) * (LD0 / 32), I_SQ = (DM / 64) * (DM / 32), I_CIN = (DM / 64) * (LD1 / 32);
    constexpr int NITEMS = I_FFN + I_ABIN + I_SQ + I_CIN + I_SQ;
    for (int it = gw; it < NITEMS; it += ngw) {
        if (it < I_FFN) {
            const int i = it / (3 * I_F), r = it % (3 * I_F), which = r / I_F, item = r % I_F, l = i >> 1, f = i & 1;
            bf16* gu = (bf16*)(WSP + WS_FFN + (size_t)i * SZ_FFN); bf16* dn = (bf16*)(WSP + WS_FFN + (size_t)i * SZ_FFN + SZ_GU);
            const size_t woff = (size_t)l * DM * DFF;
            const float* gk = inp(a, f ? 23 : 2) + l * DM;
            if (which == 0)      tr_item(inp(a, f ? 24 : 3) + woff, DM, DFF, gu, 1, scr, item, lane, gk);
            else if (which == 1) tr_item(inp(a, f ? 25 : 4) + woff, DM, DFF, gu, 2, scr, item, lane, gk);
            else                 tr_item(inp(a, f ? 26 : 5) + woff, DFF, DM, dn, 0, scr, item, lane);
            continue;
        }
        int r = it - I_FFN;
        if (r < I_ABIN) { tr_item(inp(a, 7), DM, LD0, (bf16*)(WSP + WS_ABIN), 0, scr, r, lane, inp(a, 6)); continue; } r -= I_ABIN;
        if (r < I_SQ) { tr_item(inp(a, 8), DM, DM, (bf16*)(WSP + WS_ABOUT), 0, scr, r, lane); continue; } r -= I_SQ;
        if (r < I_CIN) { tr_item(inp(a, 19), DM, LD1, (bf16*)(WSP + WS_CIN), 0, scr, r, lane, inp(a, 6) + DM); continue; } r -= I_CIN;
        tr_item(inp(a, 20), DM, DM, (bf16*)(WSP + WS_COUT), 0, scr, r, lane);
    }
}

__device__ __forceinline__ void norm_phase(const float* xp, const float* xs, const float* g1, const float* g2, float* of32, bf16* obf, int mode, int gw, int ngw, int lane, float* S0 = nullptr) {
    f32x4 ga[4], gb[4];
#pragma unroll
    for (int j = 0; j < 4; ++j) { ga[j] = (mode == 1) ? (f32x4){1.f, 1.f, 1.f, 1.f} : *(const f32x4*)(g1 + 4 * lane + 256 * j); gb[j] = (mode == 2) ? *(const f32x4*)(g2 + 4 * lane + 256 * j) : (f32x4){0.f, 0.f, 0.f, 0.f}; }
    for (int m = gw; m < NTOK; m += ngw) {
        const float* xrow = (mode == 1 && m >= NPROMPT) ? xs + (size_t)(m - NPROMPT) * DM : xp + (size_t)m * DM;
        f32x4 v[4]; float ss = 0.f;
#pragma unroll
        for (int j = 0; j < 4; ++j) { v[j] = *(const f32x4*)(xrow + 4 * lane + 256 * j); ss += (v[j].x * v[j].x + v[j].y * v[j].y) + (v[j].z * v[j].z + v[j].w * v[j].w); }
        const float tot = wave_sum(ss);
        const float rstd = 1.0f / sqrtf(tot * (1.0f / DM) + EPS);
        f32x4 y[4];
#pragma unroll
        for (int j = 0; j < 4; ++j) y[j] = (mode == 1) ? v[j] : v[j] * rstd * ga[j];
        if (mode == 1 && lane == 0) S0[m] = tot;
        if (mode == 1) {
#pragma unroll
            for (int j = 0; j < 4; ++j) *(f32x4*)(of32 + (size_t)m * DM + 4 * lane + 256 * j) = v[j];
        }
        if (mode >= 2) {
#pragma unroll
            for (int j = 0; j < 4; ++j) *(f32x4*)(of32 + (size_t)m * DM + 4 * lane + 256 * j) = y[j];
        }
        if (mode == 2) {
            float s2 = 0.f;
#pragma unroll
            for (int j = 0; j < 4; ++j) s2 += (y[j].x * y[j].x + y[j].y * y[j].y) + (y[j].z * y[j].z + y[j].w * y[j].w);
            const float r2 = 1.0f / sqrtf(wave_sum(s2) * (1.0f / DM) + EPS);
#pragma unroll
            for (int j = 0; j < 4; ++j) y[j] = y[j] * r2 * gb[j];
        }
        if (mode != 3) {
#pragma unroll
            for (int j = 0; j < 4; ++j) { u32x2 w; w.x = cvtpk(y[j].x, y[j].y); w.y = cvtpk(y[j].z, y[j].w); *(u32x2*)(obf + (size_t)m * DM + 4 * lane + 256 * j) = w; }
        }
    }
}

__device__ __forceinline__ void qknorm_phase(const Args& a, int layer, bf16* qkv, int gtid, int gthreads, int lane) {
    const int cpr = layer == 0 ? 256 : 160, ld = layer == 0 ? LD0 : LD1;
    const long total = (long)NTOK * cpr;
    const int l8 = lane & 7;
    for (long idx = gtid; idx < total; idx += gthreads) {
        const int m = (int)(idx / cpr), ch = (int)(idx % cpr);
        int col; const float* g; bool isq;
        if (layer == 0) { col = ch < 128 ? ch * 8 : 1536 + (ch - 128) * 8;
            if (col < 512) { g = inp(a, 9); isq = true; } else if (col < 1024) { g = inp(a, 10); isq = false; } else if (col < 2048) { g = inp(a, 16); isq = true; } else { g = inp(a, 17); isq = false; } }
        else { col = ch * 8; if (col < 1024) { g = inp(a, 21); isq = true; } else { g = inp(a, 22); isq = false; } }
        bf16* p = qkv + (size_t)m * ld + col;
        const u32x4 raw = *(const u32x4*)p;
        float x[8];
#pragma unroll
        for (int j = 0; j < 4; ++j) { x[2 * j] = __uint_as_float(raw[j] << 16); x[2 * j + 1] = __uint_as_float(raw[j] & 0xffff0000u); }
        float ss = 0.f;
#pragma unroll
        for (int j = 0; j < 8; ++j) ss += x[j] * x[j];
        ss += __shfl_xor(ss, 1); ss += __shfl_xor(ss, 2); ss += __shfl_xor(ss, 4);
        const float rstd = 1.0f / sqrtf(ss * (1.0f / 64.0f) + EPS);
        const f32x4 g0 = *(const f32x4*)(g + l8 * 8), g1v = *(const f32x4*)(g + l8 * 8 + 4);
        x[0] *= rstd * g0.x; x[1] *= rstd * g0.y; x[2] *= rstd * g0.z; x[3] *= rstd * g0.w;
        x[4] *= rstd * g1v.x; x[5] *= rstd * g1v.y; x[6] *= rstd * g1v.z; x[7] *= rstd * g1v.w;
        if (layer == 1) {
            const int t = m & (SEQ - 1);
            const float pos = (float)((l8 >> 2) ? (t & 63) : (t >> 6));
            const bool second = (l8 >> 1) & 1;
#pragma unroll
            for (int j = 0; j < 8; ++j) {
                const int i = (l8 & 1) * 8 + j;
                const float invf = __builtin_amdgcn_exp2f(-(float)i * (13.287712379549449f / 16.0f));
                const float ang = pos * invf;
                const float cs = __cosf(ang), sn = __sinf(ang);
                const float other = __shfl_xor(x[j], 2);
                x[j] = second ? (x[j] * cs + other * sn) : (x[j] * cs - other * sn);
            }
        }
        const float sc = isq ? QSCALE : 1.0f;
        u32x4 w; w.x = cvtpk(x[0] * sc, x[1] * sc); w.y = cvtpk(x[2] * sc, x[3] * sc); w.z = cvtpk(x[4] * sc, x[5] * sc); w.w = cvtpk(x[6] * sc, x[7] * sc);
        *(u32x4*)p = w;
    }
}

__device__ __forceinline__ int crow(int r, int hi) { return (r & 3) + 8 * (r >> 2) + 4 * hi; }
__device__ __forceinline__ s16x4 vtr(const LAS unsigned char* p) { return __builtin_bit_cast(s16x4, __builtin_amdgcn_ds_read_tr16_b64_v4i16((LAS v4i16_t*)p)); }
#define MFMA32(a, b, c) __builtin_amdgcn_mfma_f32_32x32x16_bf16((a), (b), (c), 0, 0, 0)

struct ModNone {
    float negM;
    __device__ __forceinline__ void cinit(f32x16& c0, f32x16& c1, int) const {
#pragma unroll
        for (int r = 0; r < 16; ++r) { c0[r] = negM; c1[r] = negM; }
    }
};
struct ModAlibi {
    float negM, slope; int qpos, hi;
    __device__ __forceinline__ void cinit(f32x16& c0, f32x16& c1, int t) const {
        const float base = (float)(qpos - t * 64 - 4 * hi);
#pragma unroll
        for (int r = 0; r < 16; ++r) { const float off = (float)((r & 3) + 8 * (r >> 2));
            c0[r] = negM - slope * fabsf(base - off); c1[r] = negM - slope * fabsf(base - (off + 32.0f)); }
    }
};
struct ModNA {
    const float* rpb_h; float negM; int r, c, cs, rs, lo, hi;
    __device__ __forceinline__ void cinit(f32x16& c0, f32x16& c1, int t) const {
        const int rid = lo + t; const bool rowok = rid >= rs && rid < rs + 8;
        const float* brow = rpb_h + clampi(rid - r + 7, 0, 14) * 31;
#pragma unroll
        for (int q = 0; q < 16; ++q) { const int kc = 4 * hi + (q & 3) + 8 * (q >> 2);
            { const int idx = clampi(kc - c + 15, 0, 30); const float bias = brow[idx] * L2E + negM; c0[q] = (rowok && (unsigned)(kc - cs) < 16u) ? bias : -INFINITY; }
            { const int k2 = kc + 32; const int idx = clampi(k2 - c + 15, 0, 30); const float bias = brow[idx] * L2E + negM; c1[q] = (rowok && (unsigned)(k2 - cs) < 16u) ? bias : -INFINITY; } }
    }
};

template <int DV, bool PIPE, class Mod, int VAR = 0>
__device__ __forceinline__ void attn_loop(LAS unsigned char* lds, const bf16* Kg, const bf16* Vg, int ld, int nt,
                                          const bf16x8 (&qr)[4], f32x16 (&o)[DV / 32], float& l, const Mod& mod, int tid, int lane, int r32, int hi) {
    constexpr int KROW = 144, VROW = DV * 2 + 64, KSLOT = 64 * KROW, VSLOT = 64 * VROW, VBASE = 3 * KSLOT;
    const int lkv = tid >> 3, lch = tid & 7;
    const bf16* kp = Kg + (size_t)lkv * ld + lch * 8;
    const bf16* vp = Vg + (size_t)lkv * ld + lch * 8;
    u32x4 kreg = *(const u32x4*)kp, vreg0 = *(const u32x4*)vp, vreg1 = (u32x4){0u, 0u, 0u, 0u};
    if (DV == 128) vreg1 = *(const u32x4*)(vp + 64);
    LAS unsigned char* kdst = lds + lkv * KROW + lch * 16;
    LAS unsigned char* vdst = lds + VBASE + lkv * VROW + lch * 16;
    const LAS unsigned char* kfr = lds + r32 * KROW + hi * 16;
    const LAS unsigned char* vfr = lds + VBASE + (4 * hi + ((lane & 15) >> 2)) * VROW + (16 * ((lane >> 4) & 1) + 4 * (lane & 3)) * 2;
#define ATT_LOADT(tt) do { const size_t adv_ = (size_t)(tt) * 64 * ld; kreg = *(const u32x4*)(kp + adv_); vreg0 = *(const u32x4*)(vp + adv_); if (DV == 128) vreg1 = *(const u32x4*)(vp + adv_ + 64); } while (0)
#define ATT_STORE(slot) do { *(LAS u32x4*)(kdst + (slot) * KSLOT) = kreg; *(LAS u32x4*)(vdst + (slot) * VSLOT) = vreg0; if (DV == 128) *(LAS u32x4*)(vdst + (slot) * VSLOT + 128) = vreg1; } while (0)
#define ATT_QK(S0, S1, slot) do { _Pragma("unroll") for (int d0 = 0; d0 < 4; ++d0) { \
        const bf16x8 k0_ = *(const LAS bf16x8*)(kfr + (slot) * KSLOT + d0 * 32), k1_ = *(const LAS bf16x8*)(kfr + (slot) * KSLOT + 32 * KROW + d0 * 32); \
        S0 = MFMA32(k0_, qr[d0], S0); S1 = MFMA32(k1_, qr[d0], S1); } } while (0)
    __syncthreads();
    ATT_STORE(0);
    f32x16 s0, s1;
    if (PIPE) {
        __syncthreads();
        ATT_LOADT(nt > 1 ? 1 : 0);
        mod.cinit(s0, s1, 0);
        ATT_QK(s0, s1, 0);
    } else {
        ATT_LOADT(nt > 1 ? 1 : 0);
    }
    int sc = 0, sn = 1, snn = 2;
    for (int t = 0; t < nt; ++t) {
        if (!(VAR & 8)) ATT_STORE(sn);
        __syncthreads();
        if (!(VAR & 8)) { const int tn = t + 2 < nt ? t + 2 : nt - 1; ATT_LOADT(tn); }
        __builtin_amdgcn_sched_barrier(0);
        f32x16 n0, n1;
        if (PIPE) {
            mod.cinit(n0, n1, t + 1);
            if (!(VAR & 4)) ATT_QK(n0, n1, sn);
        } else {
            mod.cinit(s0, s1, t);
            if (!(VAR & 4)) ATT_QK(s0, s1, sc);
        }
        float rs = 0.f;
#pragma unroll
        for (int r = 0; r < 16; ++r) { if (!(VAR & 1)) { s0[r] = __builtin_amdgcn_exp2f(s0[r]); s1[r] = __builtin_amdgcn_exp2f(s1[r]); } rs += s0[r] + s1[r]; }
        l += rs;
        bf16x8 pa[4];
        { u32x4 w;
          w.x = cvtpk(s0[0], s0[1]); w.y = cvtpk(s0[2], s0[3]); w.z = cvtpk(s0[4], s0[5]); w.w = cvtpk(s0[6], s0[7]); pa[0] = __builtin_bit_cast(bf16x8, w);
          w.x = cvtpk(s0[8], s0[9]); w.y = cvtpk(s0[10], s0[11]); w.z = cvtpk(s0[12], s0[13]); w.w = cvtpk(s0[14], s0[15]); pa[1] = __builtin_bit_cast(bf16x8, w);
          w.x = cvtpk(s1[0], s1[1]); w.y = cvtpk(s1[2], s1[3]); w.z = cvtpk(s1[4], s1[5]); w.w = cvtpk(s1[6], s1[7]); pa[2] = __builtin_bit_cast(bf16x8, w);
          w.x = cvtpk(s1[8], s1[9]); w.y = cvtpk(s1[10], s1[11]); w.z = cvtpk(s1[12], s1[13]); w.w = cvtpk(s1[14], s1[15]); pa[3] = __builtin_bit_cast(bf16x8, w); }
        if (!(VAR & 2)) {
#pragma unroll
        for (int db = 0; db < DV / 32; ++db)
#pragma unroll
            for (int c = 0; c < 4; ++c) {
                const s16x4 lo4 = vtr(vfr + sc * VSLOT + (16 * c) * VROW + db * 64), hi4 = vtr(vfr + sc * VSLOT + (16 * c + 8) * VROW + db * 64);
                const bf16x8 vf = (bf16x8){lo4[0], lo4[1], lo4[2], lo4[3], hi4[0], hi4[1], hi4[2], hi4[3]};
                o[db] = MFMA32(vf, pa[c], o[db]);
            }
        } else { o[0][0] += __builtin_bit_cast(float, (int)pa[0][0] + (int)pa[1][1] + (int)pa[2][2] + (int)pa[3][3]); }
        if (PIPE) { s0 = n0; s1 = n1; }
        { const int tmp = sc; sc = sn; sn = snn; snn = tmp; }
    }
#undef ATT_LOADT
#undef ATT_STORE
#undef ATT_QK
}

__device__ __forceinline__ void load_q(bf16x8 (&qr)[4], const bf16* qrow, int hi) {
#pragma unroll
    for (int d0 = 0; d0 < 4; ++d0) qr[d0] = *(const bf16x8*)(qrow + d0 * 16 + hi * 8);
}
__device__ __forceinline__ void store_o32(bf16* dst  , const f32x16& v, int hi) {
#pragma unroll
    for (int g = 0; g < 4; ++g) { u32x2 w; w.x = cvtpk(v[4 * g], v[4 * g + 1]); w.y = cvtpk(v[4 * g + 2], v[4 * g + 3]); *(u32x2*)(dst + 8 * g + 4 * hi) = w; }
}

template <int VAR>
__device__ __forceinline__ void gqa_unit(LAS unsigned char* lds, const bf16* qkv, bf16* O, float negM, int b, int head, int qb, int tid, int wid, int lane) {
    asm volatile("" : "+v"(tid));
    lane = tid & 63; const int r32 = lane & 31, hi = lane >> 5;
    const size_t tok0 = (size_t)b * SEQ, qtok = tok0 + qb * 256 + wid * 32 + r32;
    bf16x8 qr[4]; load_q(qr, qkv + qtok * LD1 + head * 64, hi);
    const bf16* Kg = qkv + tok0 * LD1 + 1024 + (head >> 2) * 64;
    f32x16 o[2]; o[0] = (f32x16){}; o[1] = (f32x16){};
    float l = 0.f;
    ModNone mod; mod.negM = negM;
    attn_loop<64, true, ModNone, VAR>(lds, Kg, Kg + 256, LD1, SEQ / 64, qr, o, l, mod, tid, lane, r32, hi);
    const float inv = 1.0f / (l + __shfl_xor(l, 32));
    bf16* orow = O + qtok * DM + head * 64;
    store_o32(orow, o[0] * inv, hi); store_o32(orow + 32, o[1] * inv, hi);
}

__device__ __forceinline__ void na_unit(LAS unsigned char* lds, const bf16* qkv, bf16* O, const float* rpb, float negM, int b, int h, int g, int tid, int wid, int lane) {
    asm volatile("" : "+v"(tid));
    lane = tid & 63; const int r32 = lane & 31, hi = lane >> 5;
    const int r = 4 * g + (wid >> 1), c = 32 * (wid & 1) + r32;
    const size_t tok0 = (size_t)b * SEQ, qtok = tok0 + r * 64 + c;
    const int lo = clampi(4 * g - 4, 0, 24), hirow = clampi(4 * g - 1, 0, 24) + 7;
    bf16x8 qr[4]; load_q(qr, qkv + qtok * LD0 + 1536 + h * 64, hi);
    const bf16* Kg = qkv + (tok0 + (size_t)lo * 64) * LD0 + 2048 + h * 64;
    f32x16 o[2]; o[0] = (f32x16){}; o[1] = (f32x16){};
    float l = 0.f;
    ModNA mod; mod.negM = negM; mod.rpb_h = rpb + h * 15 * 31; mod.r = r; mod.c = c; mod.cs = clampi(c - 8, 0, 48); mod.rs = clampi(r - 4, 0, 24); mod.lo = lo; mod.hi = hi;
    attn_loop<64, true, ModNA>(lds, Kg, Kg + 512, LD0, hirow - lo + 1, qr, o, l, mod, tid, lane, r32, hi);
    const float inv = 1.0f / (l + __shfl_xor(l, 32));
    bf16* orow = O + qtok * DM + 512 + h * 64;
    store_o32(orow, o[0] * inv, hi); store_o32(orow + 32, o[1] * inv, hi);
}

__device__ __forceinline__ void diff_unit(LAS unsigned char* lds, const bf16* qkv, bf16* O, float* stash  , const float* subg, float lam, float post, float negM, int b, int h, int qb, int tid, int wid, int lane) {
    asm volatile("" : "+v"(tid));
    lane = tid & 63; const int r32 = lane & 31, hi = lane >> 5;
    const int qpos = qb * 256 + wid * 32 + r32;
    const size_t tok0 = (size_t)b * SEQ, qtok = tok0 + qpos;
    ModAlibi mod; mod.negM = negM; mod.slope = __builtin_amdgcn_exp2f(-2.0f * (float)(h + 1)) * L2E; mod.qpos = qpos; mod.hi = hi;
    const bf16* Vg = qkv + tok0 * LD0 + 1024 + h * 128;
#pragma unroll 1
    for (int c = 0; c < 2; ++c) {
        bf16x8 qr[4]; load_q(qr, qkv + qtok * LD0 + h * 128 + c * 64, hi);
        const bf16* Kg = qkv + tok0 * LD0 + 512 + h * 128 + c * 64;
        f32x16 o[4];
#pragma unroll
        for (int db = 0; db < 4; ++db) o[db] = (f32x16){};
        float l = 0.f;
        attn_loop<128, false, ModAlibi>(lds, Kg, Vg, LD0, SEQ / 64, qr, o, l, mod, tid, lane, r32, hi);
        const float coef = (c == 0 ? 1.0f : -lam) / (l + __shfl_xor(l, 32));
        f32x4* st = (f32x4*)(stash + (size_t)tid * 64);
        if (c == 0) {
#pragma unroll
            for (int db = 0; db < 4; ++db)
#pragma unroll
                for (int g = 0; g < 4; ++g) st[db * 4 + g] = (f32x4){o[db][4 * g], o[db][4 * g + 1], o[db][4 * g + 2], o[db][4 * g + 3]} * coef;
        } else {
            float ss = 0.f;
#pragma unroll
            for (int db = 0; db < 4; ++db)
#pragma unroll
                for (int g = 0; g < 4; ++g) { const f32x4 p = st[db * 4 + g];
#pragma unroll
                    for (int e = 0; e < 4; ++e) { o[db][4 * g + e] = p[e] + o[db][4 * g + e] * coef; ss += o[db][4 * g + e] * o[db][4 * g + e]; } }
            ss += __shfl_xor(ss, 32);
            const float rstd = post / sqrtf(ss * (1.0f / 128.0f) + EPS);
            bf16* orow = O + qtok * DM + h * 128;
#pragma unroll
            for (int db = 0; db < 4; ++db) {
                f32x16 v = o[db];
#pragma unroll
                for (int g = 0; g < 4; ++g) { const f32x4 gg = *(const f32x4*)(subg + 32 * db + 8 * g + 4 * hi);
                    v[4 * g] *= rstd * gg.x; v[4 * g + 1] *= rstd * gg.y; v[4 * g + 2] *= rstd * gg.z; v[4 * g + 3] *= rstd * gg.w; }
                store_o32(orow + 32 * db, v, hi);
            }
        }
    }
}

__global__ void __launch_bounds__(NTHREADS, 2) trunk_fwd(Args a) {
    extern __shared__ __attribute__((aligned(16))) unsigned char lds_raw[];
    LAS unsigned char* lds = (LAS unsigned char*)lds_raw;
#define G (kargs()->grid)
#define bid (opaque_bid())
#define gw (bid * NWAVES + wave)
#define ngw (G * NWAVES)
#define X (kargs()->out)
#define XN ((bf16*)(WSP + WS_XN))
#define BIG ((bf16*)(WSP + WS_BIG))
#define SS(k) ((float*)(WSP + WS_S) + (size_t)(k) * NTOK)

    for (int ph = kargs()->lo; ph < kargs()->hi; ++ph) {
        int tid_ = threadIdx.x; asm volatile("" : "+v"(tid_));
        const int tid = tid_, lane = tid & 63, wave = __builtin_amdgcn_readfirstlane(tid >> 6);
        if (ph == 0) {
            convert_weights(a, lds, gw, ngw, wave, lane);
            { float* Sz = SS(1); for (int i = bid * NTHREADS + tid; i < 7 * NTOK; i += G * NTHREADS) Sz[i] = 0.f; }
            norm_phase(inp(a, 0), inp(a, 1), nullptr, nullptr, X, XN, 1, gw, ngw, lane, SS(0));
        } else if (ph == 17) {
            norm_phase(X, nullptr, inp(a, 27) + DM, nullptr, X, nullptr, 3, gw, ngw, lane);
        } else {
            const int L = (ph - 1) >> 3, s = (ph - 1) & 7;
            if (s == 0 || s == 6) {
                const int i = 2 * L + (s == 6);
                const bf16* A = (s == 6) ? (const bf16*)(WSP + WS_XB2) : XN;
                const float* Sa = (s == 6) ? SS(2 + 4 * L) : (L == 0 ? SS(0) : SS(3));
                const float* Sb = (s == 0 && L == 1) ? SS(4) : nullptr;
                pg8::Gemm g{A, (const bf16*)(WSP + WS_FFN + (size_t)i * SZ_FFN), NTOK, 2 * DFF, DM};
                pg8::StaticOrder S; S.init(NTOK, 2 * DFF, G, bid);
                pg8::EpiSwiglu2 E{BIG, DFF, Sa, Sb};
                pg8::gemm_phase<pg8::EpiSwiglu2, pg8::StaticOrder, true, true>(lds, g, S, E);
            } else if (s == 1 || s == 7) {
                const int i = 2 * L + (s == 7);
                pg8::Gemm g{BIG, (const bf16*)(WSP + WS_FFN + (size_t)i * SZ_FFN + SZ_GU), NTOK, DM, DFF};
                pg8::StaticOrder S; S.init(NTOK, DM, G, bid);
                pg8::EpiRes2 E;
                E.xr = X; E.alpha = 0.5f * (float)kargs()->ascale; E.S2 = nullptr; E.Sin = nullptr; E.gin = nullptr; E.gout = nullptr;
                if (s == 1) { E.xb = XN; E.S1 = SS(1 + 4 * L); if (L == 1) { E.Sin = SS(3); E.gin = inp(a, 27); } }
                else if (L == 0) { E.xb = XN; E.S1 = SS(3); E.S2 = SS(4); E.gout = inp(a, 27); }
                else { E.xb = nullptr; E.S1 = SS(7); }
                pg8::gemm_phase<pg8::EpiRes2, pg8::StaticOrder, true, true>(lds, g, S, E);
            } else if (s == 5) {
                pg8::Gemm g{XN, (const bf16*)(WSP + (L == 0 ? WS_ABOUT : WS_COUT)), NTOK, DM, DM};
                pg8::StaticOrder S; S.init(NTOK, DM, G, bid);
                pg8::EpiRes2 E;
                E.xr = X; E.alpha = 1.0f * (float)kargs()->ascale; E.xb = (bf16*)(WSP + WS_XB2); E.S1 = SS(2 + 4 * L); E.S2 = nullptr; E.Sin = nullptr; E.gin = nullptr; E.gout = nullptr;
                pg8::gemm_phase<pg8::EpiRes2, pg8::StaticOrder, true, true>(lds, g, S, E);
            } else if (s == 2 && L == 0) {
                pg8::Gemm g{XN, (const bf16*)(WSP + WS_ABIN), NTOK, LD0, DM};
                pg8::StaticOrder S; S.init(NTOK, LD0, G, bid);
                pg8::EpiRow E{BIG, LD0, SS(1)};
                pg8::gemm_phase<pg8::EpiRow, pg8::StaticOrder, true, true>(lds, g, S, E);
            } else if (s == 2) {
                pg8::Gemm g{XN, (const bf16*)(WSP + WS_CIN), NTOK, LD1, DM};
                pg8::StaticOrder S; S.init(NTOK, LD1, G, bid);
                pg8::EpiRow E{BIG, LD1, SS(5)};
                pg8::gemm_phase<pg8::EpiRow, pg8::StaticOrder, true, true>(lds, g, S, E);
            } else if (s == 3) {
                qknorm_phase(a, L, BIG, bid * NTHREADS + tid, G * NTHREADS, lane);
            } else {
                if (L == 0) {
                    const float d1 = wave_sum(inp(a, 11)[lane] * inp(a, 12)[lane]), d2 = wave_sum(inp(a, 13)[lane] * inp(a, 14)[lane]);
                    const float lambda_init = 0.2f;
                    const float lam = uni(__expf(d1) - __expf(d2) + lambda_init);
                    const float negMa = uni(-(64.0f * QSCALE * 1.01f) * wave_max(fabsf(inp(a, 9)[lane])) * wave_max(fabsf(inp(a, 10)[lane])));
                    float rmax = 0.f;
                    for (int i = lane; i < 8 * 15 * 31; i += 64) rmax = fmaxf(rmax, inp(a, 18)[i]);
                    const float negMb = uni(-(64.0f * QSCALE * 1.01f) * wave_max(fabsf(inp(a, 16)[lane])) * wave_max(fabsf(inp(a, 17)[lane])) - wave_max(rmax) * L2E);
                    for (int u = bid; u < 1536 + 3072; u += G) {
                        if (u < 1536) {
#ifndef NO_DIFF
 diff_unit(lds, BIG, XN, (float*)(WSP + WS_STASH) + (size_t)bid * 64 * NTHREADS, inp(a, 15), lam, 1.0f - lambda_init, negMa, u >> 5, (u >> 3) & 3, u & 7, tid, wave, lane);
#endif
 }
                        else { const int v = u - 1536;
#ifndef NO_NA
 na_unit(lds, BIG, XN, inp(a, 18), negMb, v >> 6, (v >> 3) & 7, v & 7, tid, wave, lane);
#endif
 }
                    }
                } else {
                    const float negMc = uni(-(64.0f * QSCALE * 1.01f) * wave_max(fabsf(inp(a, 21)[lane])) * wave_max(fabsf(inp(a, 22)[lane])));
                    for (int u = bid; u < NBATCH * 16 * 8; u += G) {
#ifndef NO_GQA
 gqa_unit<0>(lds, BIG, XN, negMc, u >> 7, (u >> 3) & 15, u & 7, tid, wave, lane);
#endif
 }
#ifdef PROBE_VAR
                    for (int u = bid; u < NBATCH * 16 * 8; u += G) gqa_unit<PROBE_VAR>(lds, BIG, BIG + (size_t)NTOK * LD1, negMc, u >> 7, (u >> 3) & 15, u & 7, tid, wave, lane);
#endif
                }
            }
        }
        if (ph + 1 < kargs()->hi) cg::this_grid().sync();
    }
}

#undef G
#undef bid
#undef gw
#undef ngw
#undef X
#undef XN
#undef BIG
#undef SS
#ifndef N_LAUNCH_MODE
#define N_LAUNCH_MODE 0
#endif
extern "C" void kernel_launch(void* const* d_in, const int* in_sizes, int n_in, void* d_out, int out_size, void* d_ws, size_t ws_size, hipStream_t stream) {
    static int grid = 0;
    if (grid == 0) {
        if (n_in != 28 || out_size != NTOK * DM || ws_size < WS_END) { fprintf(stderr, "kernel_launch: unexpected shapes (n_in %d out %d ws %zu)\n", n_in, out_size, ws_size); grid = -1; return; }
        int dev = 0, cus = 0, per_cu = 0;
        if (hipGetDevice(&dev) != hipSuccess || hipDeviceGetAttribute(&cus, hipDeviceAttributeMultiprocessorCount, dev) != hipSuccess) { grid = -1; return; }
        if (hipFuncSetAttribute((const void*)trunk_fwd, hipFuncAttributeMaxDynamicSharedMemorySize, LDS_BYTES) != hipSuccess) { fprintf(stderr, "kernel_launch: hipFuncSetAttribute failed\n"); grid = -1; return; }
        if (hipOccupancyMaxActiveBlocksPerMultiprocessor(&per_cu, (const void*)trunk_fwd, NTHREADS, LDS_BYTES) != hipSuccess || per_cu < 1) { fprintf(stderr, "kernel_launch: occupancy query says %d\n", per_cu); per_cu = 1; }
        (void)hipGetLastError();
        grid = cus * 1;
    }
    if (grid < 0) return;
    Args a{};
    for (int i = 0; i < 28; ++i) a.in[i] = (const float*)d_in[i];
    a.out = (float*)d_out; a.ws = (unsigned char*)d_ws; a.grid = grid; a.ascale = 1;
#if N_LAUNCH_MODE == 1
    for (int ph = 0; ph < NPHASES; ++ph) { a.lo = ph; a.hi = ph + 1; hipLaunchKernelGGL(trunk_fwd, dim3(grid), dim3(NTHREADS), LDS_BYTES, stream, a); }
#elif defined(PROBE_PH)
    const int cuts[4][2] = {{0, PROBE_PH + 1}, {PROBE_PH, PROBE_PH + 1}, {PROBE_PH + 1, NPHASES}, {0, 0}};
    for (int li = 0; li < 3; ++li) { a.lo = cuts[li][0]; a.hi = cuts[li][1]; a.ascale = (li == 1) ? 0 : 1; void* args[] = {&a};
        hipError_t e = hipLaunchCooperativeKernel((const void*)trunk_fwd, dim3(grid), dim3(NTHREADS), args, LDS_BYTES, stream);
        if (e != hipSuccess) fprintf(stderr, "kernel_launch: cooperative launch failed: %s (grid %d)\n", hipGetErrorString(e), grid); }
#else
    a.lo = 0; a.hi = NPHASES;
    void* args[] = {&a};
    hipError_t e = hipLaunchCooperativeKernel((const void*)trunk_fwd, dim3(grid), dim3(NTHREADS), args, LDS_BYTES, stream);
    if (e != hipSuccess) fprintf(stderr, "kernel_launch: cooperative launch failed: %s (grid %d)\n", hipGetErrorString(e), grid);
#endif
}
```

```cpp
#include <hip/hip_runtime.h>
#include <cstdio>
#include <cstdint>
#include <cmath>

#include <hip/hip_cooperative_groups.h>
namespace cg = cooperative_groups;

#define LAS __attribute__((address_space(3)))
typedef unsigned short bf16;
typedef float f32x4 __attribute__((ext_vector_type(4)));
typedef float f32x16 __attribute__((ext_vector_type(16)));
typedef short bf16x8 __attribute__((ext_vector_type(8)));
typedef short s16x4 __attribute__((ext_vector_type(4)));
typedef short v4i16_t __attribute__((ext_vector_type(4)));
typedef unsigned u32x4 __attribute__((ext_vector_type(4)));
typedef unsigned u32x2 __attribute__((ext_vector_type(2)));
typedef float f32x2_t __attribute__((ext_vector_type(2)));
typedef __bf16 bf16x2_t __attribute__((ext_vector_type(2)));

constexpr int NTOK = 98304, NPROMPT = 65536, DM = 1024, DFF = 2816, SEQ = 2048, NBATCH = 48;
constexpr int LD0 = 3072, LD1 = 1536;
constexpr float EPS = 1e-6f, L2E = 1.4426950408889634f;
constexpr float QSCALE = 0.125f * L2E;
constexpr int NWAVES = 8, NTHREADS = 512;
constexpr int LDS_BYTES = 147456;
constexpr int NPHASES = 16;

constexpr size_t MiB = 1u << 20;
constexpr size_t SZ_GU = (size_t)2 * DFF * DM * 2, SZ_D = (size_t)DM * DFF * 2, SZ_FFN = SZ_GU + SZ_D;
constexpr size_t WS_FFN = 0;
constexpr size_t WS_ABIN = 4 * SZ_FFN, WS_ABOUT = WS_ABIN + (size_t)LD0 * DM * 2, WS_CIN = WS_ABOUT + (size_t)DM * DM * 2, WS_COUT = WS_CIN + (size_t)LD1 * DM * 2;
constexpr size_t WS_WEND = WS_COUT + (size_t)DM * DM * 2;
constexpr size_t WS_XN = 96 * MiB;
constexpr size_t WS_BIG = 288 * MiB;
constexpr size_t WS_S = 80 * MiB;
constexpr size_t WS_CTL = 84 * MiB, CTL_BYTES = 65536;
constexpr size_t WS_XB2 = 832 * MiB;
constexpr size_t WS_STASH = 864 * MiB;
constexpr size_t WS_END = 1024 * MiB;
static_assert(WS_WEND <= WS_S && WS_S + 8 * (size_t)NTOK * 4 <= WS_XN && WS_BIG + (size_t)NTOK * DFF * 2 <= WS_XB2 && WS_XB2 + (size_t)NTOK * DM * 2 <= WS_END && WS_STASH + 256 * 64 * 512 * 4 <= WS_END && WS_XN + (size_t)NTOK * DM * 2 <= WS_BIG && WS_BIG + (size_t)NTOK * LD0 * 2 <= WS_END, "d_ws map");

struct Args { const float* in[28]; float* out; unsigned char* ws; int lo, hi, grid, ascale, li, pad2; };
__device__ __forceinline__ int opaque_bid() { int b = blockIdx.x; asm volatile("" : "+s"(b)); return b; }
typedef const __attribute__((address_space(4))) Args* KArgs;
__device__ __forceinline__ KArgs kargs() { KArgs p = (KArgs)__builtin_amdgcn_kernarg_segment_ptr(); asm volatile("" : "+s"(p)); return p; }
#define inp(a_, i_) (kargs()->in[(i_)])
#define WSP (kargs()->ws)
namespace pg8 {
#define PG8_LAS __attribute__((address_space(3)))
typedef unsigned short bf16_t;
typedef short bf16x8 __attribute__((ext_vector_type(8)));
typedef float f32x4 __attribute__((ext_vector_type(4)));
typedef unsigned u32x4 __attribute__((ext_vector_type(4)));
constexpr int BM = 256, BK = 64, HALF = 128, HTB = HALF * BK * 2  , STAGE_BYTES = 8 * HTB, NXCD = 8, WGM = 8;

__host__ __device__ __forceinline__ int lds_byte(int r, int c) { const int st = (r >> 4) * 2 + (c >> 5), rr = r & 15, cc = c & 31, ob = rr * 64 + cc * 2; return st * 1024 + (ob ^ (((ob >> 9) & 1) << 5)); }
__host__ __device__ __forceinline__ void stage_rc(int b, int& R, int& C) { const int st = b / 1024, sb = b % 1024, swz = sb ^ (((sb >> 9) & 1) << 5); R = (st >> 1) * 16 + swz / 64; C = (st & 1) * 32 + (swz % 64) / 2; }
__host__ __device__ __forceinline__ int perm32(int rho) { const int n = rho >> 4, i = rho & 15; return 8 * (i >> 2) + 4 * n + (i & 3); }

struct Unit { int pm, pn; };
struct Gemm { const bf16_t* A; const bf16_t* Bt; int M, N, K; };

struct StaticOrder {
    int nM, nN, nwg, G, c;
    __host__ __device__ void init(int M, int N, int G_, int c_) { nM = M / BM; nN = N / BM; nwg = nM * nN; G = G_; c = c_; }
    __host__ __device__ bool next(int i, Unit& u) const {
        const long L = (long)i * G + c; if (L >= nwg) return false;
        int wgid = (int)L; { const int q = nwg / NXCD, r = nwg % NXCD, xcd = wgid % NXCD, off = wgid / NXCD; wgid = (xcd < r ? xcd * (q + 1) : r * (q + 1) + (xcd - r) * q) + off; }
        const int nig = WGM * nN, gid = wgid / nig, fm = gid * WGM, gsz = (nM - fm) < WGM ? (nM - fm) : WGM;
        u.pm = fm + ((wgid % nig) % gsz); u.pn = (wgid % nig) / gsz; return true;
    }
    __device__ __forceinline__ void a_ready(const Unit&) const {}
    __device__ __forceinline__ void done(const Unit&) const {}
};

__device__ __forceinline__ unsigned cvt_pk_bf16(float lo, float hi) { unsigned r; asm volatile("v_cvt_pk_bf16_f32 %0, %1, %2" : "=v"(r) : "v"(lo), "v"(hi)); return r; }
typedef float f32x2 __attribute__((ext_vector_type(2)));
__device__ __forceinline__ f32x2 gelu_pk(f32x2 v) {
    const f32x2 av = __builtin_elementwise_abs(v), d = av * 0.2316418882f + 1.0f;
    f32x2 t; t.x = __builtin_amdgcn_rcpf(d.x); t.y = __builtin_amdgcn_rcpf(d.y);
    f32x2 q = t * 0.5307027145f + (-0.7265760135f); q = q * t + 0.7107068705f; q = q * t + (-0.142248368f); q = q * t + 0.127414796f; q = q * t;
    const f32x2 s = (v * v) * (-0.72134752044f);
    f32x2 e; e.x = __builtin_amdgcn_exp2f(s.x); e.y = __builtin_amdgcn_exp2f(s.y);
    const f32x2 m = v * (q * e), r = v - m;
    f32x2 o; o.x = v.x < 0.f ? m.x : r.x; o.y = v.y < 0.f ? m.y : r.y; return o;
}

template <int ACT  > struct EpiBf16 {
    static constexpr bool PERM = true, AFTER_DRAIN = false; static_assert(ACT == 0 || ACT == 1, "EpiBf16: ACT is 0 (none) or 1 (gelu_pk)");
    bf16_t* O; int ldc; const float* bias; int split_cols; size_t split_stride; float scale0;
    __device__ __forceinline__ void operator()(const f32x4 (&acc)[2][2][4][2], const Unit& u, int wr, int wc, int fr, int fq) const {
        const int row0 = u.pm * BM + wr * 64 + fr; int colt = u.pn * BM; bf16_t* base = O;
        float sc = 1.f; if (split_cols) { const int t = colt / split_cols; base += (size_t)t * split_stride; colt -= t * split_cols; if (t == 0) sc = scale0; }
        const int col0 = colt + wc * 32 + 8 * fq, bcol0 = u.pn * BM + wc * 32 + 8 * fq;
        f32x4 bv[2][2];
#pragma unroll
        for (int bj = 0; bj < 2; ++bj)
#pragma unroll
            for (int n = 0; n < 2; ++n) bv[bj][n] = bias ? *(const f32x4*)(bias + bcol0 + bj * HALF + 4 * n) : (f32x4){0.f, 0.f, 0.f, 0.f};
#pragma unroll
        for (int ai = 0; ai < 2; ++ai)
#pragma unroll
            for (int m = 0; m < 4; ++m) { bf16_t* rowp = base + (size_t)(row0 + ai * HALF + m * 16) * ldc + col0;
#pragma unroll
                for (int bj = 0; bj < 2; ++bj) { f32x4 v0 = acc[ai][bj][m][0] + bv[bj][0], v1 = acc[ai][bj][m][1] + bv[bj][1];
                    if (ACT == 1) { f32x2 a = gelu_pk((f32x2){v0[0], v0[1]}), b = gelu_pk((f32x2){v0[2], v0[3]}), c = gelu_pk((f32x2){v1[0], v1[1]}), d = gelu_pk((f32x2){v1[2], v1[3]});
                        v0 = (f32x4){a.x, a.y, b.x, b.y}; v1 = (f32x4){c.x, c.y, d.x, d.y}; }
                    v0 = v0 * sc; v1 = v1 * sc; u32x4 w; w.x = cvt_pk_bf16(v0[0], v0[1]); w.y = cvt_pk_bf16(v0[2], v0[3]); w.z = cvt_pk_bf16(v1[0], v1[1]); w.w = cvt_pk_bf16(v1[2], v1[3]);
                    *(u32x4*)(rowp + bj * HALF) = w; } }
    }
};

struct EpiSwiglu {
    static constexpr bool PERM = true, AFTER_DRAIN = false;
    bf16_t* H; int ldh;
    __device__ __forceinline__ void operator()(const f32x4 (&acc)[2][2][4][2], const Unit& u, int wr, int wc, int fr, int fq) const {
        const int row0 = u.pm * BM + wr * 64 + fr; const int col0 = u.pn * HALF + wc * 32 + 8 * fq;
#pragma unroll
        for (int ai = 0; ai < 2; ++ai)
#pragma unroll
            for (int m = 0; m < 4; ++m) { bf16_t* rowp = H + (size_t)(row0 + ai * HALF + m * 16) * ldh + col0;
                float hv[8];
#pragma unroll
                for (int n = 0; n < 2; ++n)
#pragma unroll
                    for (int e = 0; e < 4; ++e) { const float g = acc[ai][0][m][n][e], up = acc[ai][1][m][n][e];
                        const float sg = __builtin_amdgcn_rcpf(1.0f + __builtin_amdgcn_exp2f(-1.4426950408889634f * g));
                        hv[n * 4 + e] = g * sg * up; }
                u32x4 w; w.x = cvt_pk_bf16(hv[0], hv[1]); w.y = cvt_pk_bf16(hv[2], hv[3]); w.z = cvt_pk_bf16(hv[4], hv[5]); w.w = cvt_pk_bf16(hv[6], hv[7]);
                *(u32x4*)rowp = w; }
    }
};
struct EpiRes {
    static constexpr bool PERM = true, AFTER_DRAIN = false;
    float* X; int ldc; float alpha;
    __device__ __forceinline__ void operator()(const f32x4 (&acc)[2][2][4][2], const Unit& u, int wr, int wc, int fr, int fq) const {
        const int row0 = u.pm * BM + wr * 64 + fr; const int col0 = u.pn * BM + wc * 32 + 8 * fq;
#pragma unroll
        for (int ai = 0; ai < 2; ++ai)
#pragma unroll
            for (int m = 0; m < 4; ++m) { float* rowp = X + (size_t)(row0 + ai * HALF + m * 16) * ldc + col0;
#pragma unroll
                for (int bj = 0; bj < 2; ++bj) { f32x4 a = *(const f32x4*)(rowp + bj * HALF), b = *(const f32x4*)(rowp + bj * HALF + 4);
                    a += acc[ai][bj][m][0] * alpha; b += acc[ai][bj][m][1] * alpha;
                    *(f32x4*)(rowp + bj * HALF) = a; *(f32x4*)(rowp + bj * HALF + 4) = b; } }
    }
};

__device__ __forceinline__ float* SSp(int k) { return (float*)(kargs()->ws + WS_S) + (size_t)k * NTOK; }
__device__ __forceinline__ float row_rstd(const float* Sa, const float* Sb, int row) {
    float r = 1.0f / sqrtf(Sa[row] * (1.0f / 1024.0f) + 1e-6f);
    if (Sb) r *= 1.0f / sqrtf(r * r * Sb[row] * (1.0f / 1024.0f) + 1e-6f);
    return r;
}
struct EpiSwiglu2 {
    static constexpr bool PERM = true, AFTER_DRAIN = false;
    int sai, sbi;
    __device__ __forceinline__ void operator()(const f32x4 (&acc)[2][2][4][2], const Unit& u, int wr, int wc, int fr, int fq) const {
        asm volatile("" : "+v"(fr), "+v"(fq));
        const int row0 = u.pm * BM + wr * 64 + fr; const int col0 = u.pn * HALF + wc * 32 + 8 * fq;
        bf16_t* H = (bf16_t*)(kargs()->ws + WS_BIG); const int ldh = DFF; const float* Sa = SSp(sai); const float* Sb = sbi >= 0 ? SSp(sbi) : nullptr;
#pragma unroll
        for (int ai = 0; ai < 2; ++ai)
#pragma unroll
            for (int m = 0; m < 4; ++m) { const int row = row0 + ai * HALF + m * 16; bf16_t* rowp = H + (size_t)row * ldh + col0;
                const float rs = row_rstd(Sa, Sb, row);
                float hv[8];
#pragma unroll
                for (int n = 0; n < 2; ++n)
#pragma unroll
                    for (int e = 0; e < 4; ++e) { const float g = acc[ai][0][m][n][e] * rs, up = acc[ai][1][m][n][e] * rs;
                        const float sg = __builtin_amdgcn_rcpf(1.0f + __builtin_amdgcn_exp2f(-1.4426950408889634f * g));
                        hv[n * 4 + e] = g * sg * up; }
                u32x4 w; w.x = cvt_pk_bf16(hv[0], hv[1]); w.y = cvt_pk_bf16(hv[2], hv[3]); w.z = cvt_pk_bf16(hv[4], hv[5]); w.w = cvt_pk_bf16(hv[6], hv[7]);
                *(u32x4*)rowp = w; }
    }
};
struct EpiRow {
    static constexpr bool PERM = true, AFTER_DRAIN = false;
    bf16_t* O; int ldc; const float* Sa;
    __device__ __forceinline__ void operator()(const f32x4 (&acc)[2][2][4][2], const Unit& u, int wr, int wc, int fr, int fq) const {
        const int row0 = u.pm * BM + wr * 64 + fr; const int col0 = u.pn * BM + wc * 32 + 8 * fq;
#pragma unroll
        for (int ai = 0; ai < 2; ++ai)
#pragma unroll
            for (int m = 0; m < 4; ++m) { const int row = row0 + ai * HALF + m * 16; bf16_t* rowp = O + (size_t)row * ldc + col0;
                const float rs = row_rstd(Sa, nullptr, row);
#pragma unroll
                for (int bj = 0; bj < 2; ++bj) { const f32x4 v0 = acc[ai][bj][m][0] * rs, v1 = acc[ai][bj][m][1] * rs;
                    u32x4 w; w.x = cvt_pk_bf16(v0[0], v0[1]); w.y = cvt_pk_bf16(v0[2], v0[3]); w.z = cvt_pk_bf16(v1[0], v1[1]); w.w = cvt_pk_bf16(v1[2], v1[3]);
                    *(u32x4*)(rowp + bj * HALF) = w; } }
    }
};
struct EpiRes2 {
    static constexpr bool PERM = true, AFTER_DRAIN = false;
    int s1i, s2i, sini, xbsel, gsel; float alpha;
    __device__ __forceinline__ void operator()(const f32x4 (&acc)[2][2][4][2], const Unit& u, int wr, int wc, int fr, int fq) const {
        asm volatile("" : "+v"(fr), "+v"(fq));
        const int row0 = u.pm * BM + wr * 64 + fr; const int col0 = u.pn * BM + wc * 32 + 8 * fq;
        unsigned char* ws_ = kargs()->ws; float* xr = kargs()->out;
        bf16_t* xb = xbsel == 0 ? nullptr : (bf16_t*)(ws_ + (xbsel == 1 ? WS_XN : WS_XB2));
        float* S1 = SSp(s1i); float* S2 = s2i >= 0 ? SSp(s2i) : nullptr; const float* Sin = sini >= 0 ? SSp(sini) : nullptr;
        const float* gfin = kargs()->in[27]; const float* gin = gsel == 1 ? gfin : nullptr; const float* gout = gsel == 2 ? gfin : nullptr;
        f32x4 gi[2][2], go[2][2];
#pragma unroll
        for (int bj = 0; bj < 2; ++bj)
#pragma unroll
            for (int n = 0; n < 2; ++n) { gi[bj][n] = gin ? *(const f32x4*)(gin + col0 + bj * HALF + 4 * n) : (f32x4){1.f, 1.f, 1.f, 1.f};
                                          go[bj][n] = gout ? *(const f32x4*)(gout + col0 + bj * HALF + 4 * n) : (f32x4){1.f, 1.f, 1.f, 1.f}; }
#pragma unroll
        for (int ai = 0; ai < 2; ++ai)
#pragma unroll
            for (int m = 0; m < 4; ++m) { const int row = row0 + ai * HALF + m * 16; float* rowp = xr + (size_t)row * 1024 + col0;
                const float rsc = gin ? 1.0f / sqrtf(Sin[row] * (1.0f / 1024.0f) + 1e-6f) : 1.0f;
                float s1 = 0.f, s2 = 0.f;
#pragma unroll
                for (int bj = 0; bj < 2; ++bj) { f32x4 a = *(const f32x4*)(rowp + bj * HALF), b = *(const f32x4*)(rowp + bj * HALF + 4);
                    a = a * (gi[bj][0] * rsc) + acc[ai][bj][m][0] * alpha; b = b * (gi[bj][1] * rsc) + acc[ai][bj][m][1] * alpha;
                    *(f32x4*)(rowp + bj * HALF) = a; *(f32x4*)(rowp + bj * HALF + 4) = b;
                    s1 += (a[0] * a[0] + a[1] * a[1]) + (a[2] * a[2] + a[3] * a[3]) + (b[0] * b[0] + b[1] * b[1]) + (b[2] * b[2] + b[3] * b[3]);
                    a = a * go[bj][0]; b = b * go[bj][1];
                    s2 += (a[0] * a[0] + a[1] * a[1]) + (a[2] * a[2] + a[3] * a[3]) + (b[0] * b[0] + b[1] * b[1]) + (b[2] * b[2] + b[3] * b[3]);
                    if (xb) { u32x4 w; w.x = cvt_pk_bf16(a[0], a[1]); w.y = cvt_pk_bf16(a[2], a[3]); w.z = cvt_pk_bf16(b[0], b[1]); w.w = cvt_pk_bf16(b[2], b[3]);
                        *(u32x4*)(xb + (size_t)row * 1024 + col0 + bj * HALF) = w; } }
                s1 += __shfl_xor(s1, 16); s1 += __shfl_xor(s1, 32); s2 += __shfl_xor(s2, 16); s2 += __shfl_xor(s2, 32);
                if (fq == 0) { __hip_atomic_fetch_add(S1 + row, s1, __ATOMIC_RELAXED, __HIP_MEMORY_SCOPE_AGENT);
                               if (S2) __hip_atomic_fetch_add(S2 + row, s2, __ATOMIC_RELAXED, __HIP_MEMORY_SCOPE_AGENT); } }
    }
};
struct EpiQKV {
    static constexpr bool PERM = true, AFTER_DRAIN = false;
    int ldc, sai, layer;
    __device__ __forceinline__ void operator()(const f32x4 (&acc)[2][2][4][2], const Unit& u, int wr, int wc, int fr, int fq) const {
        asm volatile("" : "+v"(fr), "+v"(fq));
        const float QS = 0.125f * 1.4426950408889634f;
        bf16_t* O = (bf16_t*)(kargs()->ws + WS_BIG); const float* Sa = SSp(sai);
        const int pn = u.pn; int kind; int gi_; float sc;
        if (layer == 0) { const int reg = pn >> 1;
            kind = (reg == 2 || reg == 5) ? 0 : 1; gi_ = reg == 0 ? 9 : (reg == 1 ? 10 : (reg == 3 ? 16 : 17)); sc = (reg == 0 || reg == 3) ? QS : 1.0f; }
        else { kind = pn < 5 ? 2 : 0; gi_ = pn < 4 ? 21 : 22; sc = pn < 4 ? QS : 1.0f; }
        const float* gp = kargs()->in[gi_];
        const int row0 = u.pm * BM + wr * 64 + fr; const int col0 = pn * BM + wc * 64 + 8 * fq;
        f32x4 gg[2][2]; float invf[2][4];
#pragma unroll
        for (int bj = 0; bj < 2; ++bj)
#pragma unroll
            for (int n = 0; n < 2; ++n) gg[bj][n] = kind ? *(const f32x4*)(gp + 32 * bj + 8 * fq + 4 * n) * sc : (f32x4){1.f, 1.f, 1.f, 1.f};
#pragma unroll
        for (int n = 0; n < 2; ++n)
#pragma unroll
            for (int e = 0; e < 4; ++e) invf[n][e] = __builtin_amdgcn_exp2f(-(float)(8 * (fq & 1) + 4 * n + e) * (13.287712379549449f / 16.0f));
#pragma unroll
        for (int ai = 0; ai < 2; ++ai)
#pragma unroll
            for (int m = 0; m < 4; ++m) { const int row = row0 + ai * HALF + m * 16; bf16_t* rowp = O + (size_t)row * ldc + col0;
                const float rs = row_rstd(Sa, nullptr, row);
                f32x4 v[2][2];
#pragma unroll
                for (int bj = 0; bj < 2; ++bj)
#pragma unroll
                    for (int n = 0; n < 2; ++n) v[bj][n] = acc[ai][bj][m][n] * rs;
                if (kind) {
                    float ss = 0.f;
#pragma unroll
                    for (int bj = 0; bj < 2; ++bj)
#pragma unroll
                        for (int n = 0; n < 2; ++n) ss += (v[bj][n][0] * v[bj][n][0] + v[bj][n][1] * v[bj][n][1]) + (v[bj][n][2] * v[bj][n][2] + v[bj][n][3] * v[bj][n][3]);
                    ss += __shfl_xor(ss, 16); ss += __shfl_xor(ss, 32);
                    const float r = 1.0f / sqrtf(ss * (1.0f / 64.0f) + 1e-6f);
#pragma unroll
                    for (int bj = 0; bj < 2; ++bj)
#pragma unroll
                        for (int n = 0; n < 2; ++n) v[bj][n] = v[bj][n] * gg[bj][n] * r;
                    if (kind == 2) {
                        const int t = row & 2047;
#pragma unroll
                        for (int bj = 0; bj < 2; ++bj) { const float pos = (float)(bj ? (t & 63) : (t >> 6));
#pragma unroll
                            for (int n = 0; n < 2; ++n)
#pragma unroll
                                for (int e = 0; e < 4; ++e) { const float ang = pos * invf[n][e]; const float cs = __cosf(ang), sn = __sinf(ang);
                                    const float other = __shfl_xor(v[bj][n][e], 32);
                                    v[bj][n][e] = (fq >= 2) ? (v[bj][n][e] * cs + other * sn) : (v[bj][n][e] * cs - other * sn); } }
                    }
                }
#pragma unroll
                for (int bj = 0; bj < 2; ++bj) { u32x4 w; w.x = cvt_pk_bf16(v[bj][0][0], v[bj][0][1]); w.y = cvt_pk_bf16(v[bj][0][2], v[bj][0][3]); w.z = cvt_pk_bf16(v[bj][1][0], v[bj][1][1]); w.w = cvt_pk_bf16(v[bj][1][2], v[bj][1][3]);
                    *(u32x4*)(rowp + bj * 32) = w; }
                __builtin_amdgcn_sched_barrier(0); }
    }
};
template <class Epi, class Sched, bool ALIGN_EPI = false, bool SP2 = false>
__device__ __forceinline__ void gemm_phase(PG8_LAS unsigned char* lds, const Gemm g, const Sched& S, const Epi& E) {
    int tid_ = threadIdx.x; asm volatile("" : "+v"(tid_));
    const int tid = tid_, wid = __builtin_amdgcn_readfirstlane(tid >> 6), lane = tid & 63, wr = wid >> 2, wc = wid & 3, fr = lane & 15, fq = lane >> 4;
    const int K = g.K, nt = K / BK;
    unsigned voffA[2], voffB[2];
#pragma unroll
    for (int i = 0; i < 2; ++i) { int R, C; stage_rc(tid * 16 + i * 8192, R, C); const int Rb = Epi::PERM ? ((R & ~31) + perm32(R & 31)) : R;
        voffA[i] = (unsigned)(R * K + C) * 2u; voffB[i] = (unsigned)(Rb * K + C) * 2u; }
    const size_t kstep = (size_t)(BK * 2);
    const size_t hstep = (size_t)HALF * K * 2;
    const size_t tstep = 2 * hstep;
    const unsigned ldsw = (unsigned)wid * 1024u;
    const int aoff = lds_byte(wr * 64 + fr, fq * 8), boff = lds_byte(wc * 32 + fr, fq * 8);
#define PG8_SA(b, h) (((b) * 2 + (h)) * HTB)
#define PG8_SB(b, h) ((4 + (b) * 2 + (h)) * HTB)
#define PG8_STAGE(bufoff, gbase, voff) do { _Pragma("unroll") for (int _i = 0; _i < 2; ++_i) \
        __builtin_amdgcn_global_load_lds((const unsigned*)((const char*)(gbase) + (voff)[_i]), (PG8_LAS unsigned*)(lds + (bufoff) + ldsw + _i * 8192), 16, 0, 0); } while (0)
#define PG8_LDA(dst, b, h) do { _Pragma("unroll") for (int m = 0; m < 4; ++m) _Pragma("unroll") for (int k = 0; k < 2; ++k) dst[m][k] = *(const PG8_LAS bf16x8*)(lds + PG8_SA(b, h) + aoff + m * 2048 + k * 1024); } while (0)
#define PG8_LDB(dst, b, h) do { _Pragma("unroll") for (int n = 0; n < 2; ++n) _Pragma("unroll") for (int k = 0; k < 2; ++k) dst[n][k] = *(const PG8_LAS bf16x8*)(lds + PG8_SB(b, h) + boff + n * 2048 + k * 1024); } while (0)
#define PG8_MMA(ai, bj, At, Bt) do { __builtin_amdgcn_s_setprio(1); _Pragma("unroll") for (int m = 0; m < 4; ++m) _Pragma("unroll") for (int n = 0; n < 2; ++n) _Pragma("unroll") for (int k = 0; k < 2; ++k) \
        acc[ai][bj][m][n] = __builtin_amdgcn_mfma_f32_16x16x32_bf16(Bt[n][k], At[m][k], acc[ai][bj][m][n], 0, 0, 0); __builtin_amdgcn_s_setprio(0); } while (0)
#define PG8_WAIT_V(n) asm volatile("s_waitcnt vmcnt(" #n ")" ::: "memory")
#define PG8_WAIT_L(n) asm volatile("s_waitcnt lgkmcnt(" #n ")" ::: "memory")
#define PG8_BAR __builtin_amdgcn_s_barrier()
#define PG8_SCHED __builtin_amdgcn_sched_barrier(0)
    Unit cur, nxt; int ui = 0;
    if (!S.next(0, cur)) return;
    f32x4 acc[2][2][4][2];
#pragma unroll
    for (int a = 0; a < 2; ++a)
#pragma unroll
        for (int b = 0; b < 2; ++b)
#pragma unroll
            for (int m = 0; m < 4; ++m)
#pragma unroll
                for (int n = 0; n < 2; ++n) acc[a][b][m][n] = (f32x4){0.f, 0.f, 0.f, 0.f};
    bf16x8 At[4][2], B0[2][2], B1[2][2];
    const char* cA = (const char*)g.A + (size_t)cur.pm * tstep; const char* cB = (const char*)g.Bt + (size_t)cur.pn * tstep;
    S.a_ready(cur);
    if constexpr (SP2) {
        PG8_STAGE(PG8_SB(0, 0), cB, voffB); PG8_STAGE(PG8_SB(0, 1), cB + hstep, voffB); PG8_STAGE(PG8_SA(0, 0), cA, voffA); PG8_STAGE(PG8_SA(0, 1), cA + hstep, voffA);
        if (wr == 1) PG8_BAR;
        PG8_WAIT_V(2); PG8_BAR;
        PG8_STAGE(PG8_SB(1, 0), cB + kstep, voffB); PG8_STAGE(PG8_SA(1, 0), cA + kstep, voffA); PG8_STAGE(PG8_SB(1, 1), cB + hstep + kstep, voffB);
        PG8_WAIT_V(6); PG8_BAR;
    } else {
        PG8_STAGE(PG8_SB(0, 0), cB, voffB); PG8_STAGE(PG8_SA(0, 0), cA, voffA); PG8_STAGE(PG8_SB(0, 1), cB + hstep, voffB); PG8_STAGE(PG8_SA(0, 1), cA + hstep, voffA);
        if (wr == 1) PG8_BAR;
        PG8_WAIT_V(4); PG8_BAR;
        PG8_STAGE(PG8_SB(1, 0), cB + kstep, voffB); PG8_STAGE(PG8_SA(1, 0), cA + kstep, voffA); PG8_STAGE(PG8_SB(1, 1), cB + hstep + kstep, voffB);
        PG8_WAIT_V(6); PG8_BAR;
    }
    for (;;) {
        const bool has_next = S.next(ui + 1, nxt);
        const char* nA = has_next ? (const char*)g.A + (size_t)nxt.pm * tstep : cA; const char* nB = has_next ? (const char*)g.Bt + (size_t)nxt.pn * tstep : cB;
        for (int t = 0; t < nt; t += 2) {
            const bool last = (t == nt - 2);
            const char* a1 = cA + (size_t)(t + 1) * kstep;
            const char* a2 = last ? nA : cA + (size_t)(t + 2) * kstep; const char* b2 = last ? nB : cB + (size_t)(t + 2) * kstep;
            const char* a3 = a2 + kstep; const char* b3 = b2 + kstep;
            if (last && has_next) S.a_ready(nxt);
            if constexpr (SP2) {
            PG8_LDB(B0, 0, 0); PG8_LDB(B1, 0, 1); PG8_SCHED; PG8_LDA(At, 0, 0); PG8_STAGE(PG8_SA(1, 1), a1 + hstep, voffA);
            PG8_WAIT_V(8); PG8_WAIT_L(0); PG8_BAR; PG8_MMA(0, 0, At, B0); PG8_MMA(0, 1, At, B1); PG8_BAR; PG8_SCHED;
            PG8_LDA(At, 0, 1); PG8_STAGE(PG8_SB(0, 0), b2, voffB); PG8_STAGE(PG8_SB(0, 1), b2 + hstep, voffB); PG8_STAGE(PG8_SA(0, 0), a2, voffA);
            PG8_WAIT_V(8); PG8_WAIT_L(0); PG8_BAR; PG8_MMA(1, 0, At, B0); PG8_MMA(1, 1, At, B1); PG8_BAR; PG8_SCHED;
            PG8_LDB(B0, 1, 0); PG8_LDB(B1, 1, 1); PG8_SCHED; PG8_LDA(At, 1, 0); PG8_STAGE(PG8_SA(0, 1), a2 + hstep, voffA);
            PG8_WAIT_V(8); PG8_WAIT_L(0); PG8_BAR; PG8_MMA(0, 0, At, B0); PG8_MMA(0, 1, At, B1); PG8_BAR; PG8_SCHED;
            PG8_LDA(At, 1, 1); PG8_STAGE(PG8_SB(1, 0), b3, voffB); PG8_STAGE(PG8_SB(1, 1), b3 + hstep, voffB); PG8_STAGE(PG8_SA(1, 0), a3, voffA);
            PG8_WAIT_V(8); PG8_WAIT_L(0); PG8_BAR; PG8_MMA(1, 0, At, B0); PG8_MMA(1, 1, At, B1); PG8_BAR; PG8_SCHED;
            } else {
            PG8_LDB(B0, 0, 0); PG8_SCHED; PG8_LDA(At, 0, 0); PG8_STAGE(PG8_SA(1, 1), a1 + hstep, voffA);
            PG8_WAIT_L(8); PG8_BAR; PG8_WAIT_L(0); PG8_MMA(0, 0, At, B0); PG8_BAR; PG8_SCHED;
            PG8_LDB(B1, 0, 1); PG8_STAGE(PG8_SB(0, 0), b2, voffB);
            PG8_BAR; PG8_WAIT_L(0); PG8_MMA(0, 1, At, B1); PG8_BAR;
            PG8_LDA(At, 0, 1); PG8_STAGE(PG8_SA(0, 0), a2, voffA);
            PG8_BAR; PG8_WAIT_L(0); PG8_MMA(1, 0, At, B0); PG8_BAR; PG8_SCHED;
            PG8_STAGE(PG8_SB(0, 1), b2 + hstep, voffB);
            PG8_WAIT_V(6); PG8_BAR; PG8_MMA(1, 1, At, B1); PG8_BAR;
            PG8_LDB(B0, 1, 0); PG8_SCHED; PG8_LDA(At, 1, 0); PG8_STAGE(PG8_SA(0, 1), a2 + hstep, voffA);
            PG8_WAIT_L(8); PG8_BAR; PG8_WAIT_L(0); PG8_MMA(0, 0, At, B0); PG8_BAR; PG8_SCHED;
            PG8_LDB(B1, 1, 1); PG8_STAGE(PG8_SB(1, 0), b3, voffB);
            PG8_BAR; PG8_WAIT_L(0); PG8_MMA(0, 1, At, B1); PG8_BAR;
            PG8_LDA(At, 1, 1); PG8_STAGE(PG8_SA(1, 0), a3, voffA);
            PG8_BAR; PG8_WAIT_L(0); PG8_MMA(1, 0, At, B0); PG8_BAR; PG8_SCHED;
            PG8_STAGE(PG8_SB(1, 1), b3 + hstep, voffB);
            PG8_WAIT_V(6); PG8_BAR; PG8_MMA(1, 1, At, B1); PG8_BAR;
            }
        }
        if constexpr (ALIGN_EPI) { if (wr == 0) PG8_BAR; }
        if constexpr (!Epi::AFTER_DRAIN) { E(acc, cur, wr, wc, fr, fq); S.done(cur); }
        if (!has_next) break;
#pragma unroll
        for (int a = 0; a < 2; ++a)
#pragma unroll
            for (int b = 0; b < 2; ++b)
#pragma unroll
                for (int m = 0; m < 4; ++m)
#pragma unroll
                    for (int n = 0; n < 2; ++n) acc[a][b][m][n] = (f32x4){0.f, 0.f, 0.f, 0.f};
        cur = nxt; cA = nA; cB = nB; ++ui;
        if constexpr (ALIGN_EPI) { if (wr == 1) PG8_BAR; }
    }
    PG8_WAIT_V(0);
    if constexpr (!ALIGN_EPI) { if (wr == 0) PG8_BAR; }
    PG8_BAR;
    if constexpr (Epi::AFTER_DRAIN) { E.fused(acc, cur, wr, wc, fr, fq, lds, wid, lane); S.done(cur); }
#undef PG8_SA
#undef PG8_SB
#undef PG8_STAGE
#undef PG8_LDA
#undef PG8_LDB
#undef PG8_MMA
#undef PG8_WAIT_V
#undef PG8_WAIT_L
#undef PG8_BAR
#undef PG8_SCHED
}
}
#define N_LAUNCH_MODE 0

__device__ __forceinline__ float wave_sum(float v) {
#pragma unroll
    for (int o = 1; o < 64; o <<= 1) v += __shfl_xor(v, o);
    return v;
}
__device__ __forceinline__ float wave_max(float v) {
#pragma unroll
    for (int o = 1; o < 64; o <<= 1) v = fmaxf(v, __shfl_xor(v, o));
    return v;
}
__device__ __forceinline__ float uni(float v) { return __builtin_bit_cast(float, __builtin_amdgcn_readfirstlane(__builtin_bit_cast(int, v))); }
__device__ __forceinline__ unsigned cvtpk(float lo, float hi) { f32x2_t v = {lo, hi}; bf16x2_t b = __builtin_convertvector(v, bf16x2_t); return __builtin_bit_cast(unsigned, b); }
__device__ __forceinline__ float bf2f(unsigned short h) { return __uint_as_float((unsigned)h << 16); }
__device__ __forceinline__ int clampi(int v, int lo, int hi) { return v < lo ? lo : (v > hi ? hi : v); }

__device__ __forceinline__ void tr_item(const float* W, int K, int N, bf16* WT, int mode, LAS float* scr, int item, int lane, const float* gk = nullptr) {
    const int nblk = N / 32, kb = item / nblk, nb = item % nblk, k0 = 64 * kb, n0 = 32 * nb;
    const int drow0 = (mode == 0) ? n0 : (mode == 3) ? ((n0 & ~255) + 128 * ((n0 & 63) >> 5) + 32 * ((n0 & 255) >> 6)) : ((n0 >> 7) * 256 + (n0 & 127) + (mode == 2 ? 128 : 0));
#pragma unroll 8
    for (int i = 0; i < 32; ++i) { const int kk = 2 * i + (lane >> 5); const float gg = gk ? gk[k0 + kk] : 1.0f; scr[kk * 33 + (lane & 31)] = W[(size_t)(k0 + kk) * N + n0 + (lane & 31)] * gg; }
    asm volatile("s_waitcnt lgkmcnt(0)" ::: "memory");
    const int c = lane & 7;
#pragma unroll
    for (int j = 0; j < 4; ++j) { const int n = (lane >> 3) + 8 * j; const LAS float* s = scr + (8 * c) * 33 + n;
        u32x4 o; o.x = cvtpk(s[0 * 33], s[1 * 33]); o.y = cvtpk(s[2 * 33], s[3 * 33]); o.z = cvtpk(s[4 * 33], s[5 * 33]); o.w = cvtpk(s[6 * 33], s[7 * 33]);
        *(u32x4*)(WT + (size_t)(drow0 + n) * K + k0 + 8 * c) = o; }
    asm volatile("s_waitcnt lgkmcnt(0)" ::: "memory");
}

__device__ __forceinline__ void convert_weights(const Args& a, LAS unsigned char* lds, int gw, int ngw, int wave, int lane) {
    LAS float* scr = (LAS float*)(lds + wave * 16384);
    constexpr int I_F = (DM / 64) * (DFF / 32);
    constexpr int I_FFN = 4 * 3 * I_F;
    constexpr int I_ABIN = (DM / 64) * (LD0 / 32), I_SQ = (DM / 64) * (DM / 32), I_CIN = (DM / 64) * (LD1 / 32);
    constexpr int NITEMS = I_FFN + I_ABIN + I_SQ + I_CIN + I_SQ;
    for (int it = gw; it < NITEMS; it += ngw) {
        if (it < I_FFN) {
            const int i = it / (3 * I_F), r = it % (3 * I_F), which = r / I_F, item = r % I_F, l = i >> 1, f = i & 1;
            bf16* gu = (bf16*)(WSP + WS_FFN + (size_t)i * SZ_FFN); bf16* dn = (bf16*)(WSP + WS_FFN + (size_t)i * SZ_FFN + SZ_GU);
            const size_t woff = (size_t)l * DM * DFF;
            const float* gk = inp(a, f ? 23 : 2) + l * DM;
            if (which == 0)      tr_item(inp(a, f ? 24 : 3) + woff, DM, DFF, gu, 1, scr, item, lane, gk);
            else if (which == 1) tr_item(inp(a, f ? 25 : 4) + woff, DM, DFF, gu, 2, scr, item, lane, gk);
            else                 tr_item(inp(a, f ? 26 : 5) + woff, DFF, DM, dn, 0, scr, item, lane);
            continue;
        }
        int r = it - I_FFN;
        if (r < I_ABIN) { tr_item(inp(a, 7), DM, LD0, (bf16*)(WSP + WS_ABIN), 3, scr, r, lane, inp(a, 6)); continue; } r -= I_ABIN;
        if (r < I_SQ) { tr_item(inp(a, 8), DM, DM, (bf16*)(WSP + WS_ABOUT), 0, scr, r, lane); continue; } r -= I_SQ;
        if (r < I_CIN) { tr_item(inp(a, 19), DM, LD1, (bf16*)(WSP + WS_CIN), 3, scr, r, lane, inp(a, 6) + DM); continue; } r -= I_CIN;
        tr_item(inp(a, 20), DM, DM, (bf16*)(WSP + WS_COUT), 0, scr, r, lane);
    }
}

__device__ __forceinline__ void norm_phase(const float* xp, const float* xs, const float* g1, const float* g2, float* of32, bf16* obf, int mode, int gw, int ngw, int lane, float* S0 = nullptr) {
    f32x4 ga[4], gb[4];
#pragma unroll
    for (int j = 0; j < 4; ++j) { ga[j] = (mode == 1) ? (f32x4){1.f, 1.f, 1.f, 1.f} : *(const f32x4*)(g1 + 4 * lane + 256 * j); gb[j] = (mode == 2) ? *(const f32x4*)(g2 + 4 * lane + 256 * j) : (f32x4){0.f, 0.f, 0.f, 0.f}; }
    for (int m = gw; m < NTOK; m += ngw) {
        const float* xrow = (mode == 1 && m >= NPROMPT) ? xs + (size_t)(m - NPROMPT) * DM : xp + (size_t)m * DM;
        f32x4 v[4]; float ss = 0.f;
#pragma unroll
        for (int j = 0; j < 4; ++j) { v[j] = *(const f32x4*)(xrow + 4 * lane + 256 * j); ss += (v[j].x * v[j].x + v[j].y * v[j].y) + (v[j].z * v[j].z + v[j].w * v[j].w); }
        const float tot = wave_sum(ss);
        const float rstd = 1.0f / sqrtf(tot * (1.0f / DM) + EPS);
        f32x4 y[4];
#pragma unroll
        for (int j = 0; j < 4; ++j) y[j] = (mode == 1) ? v[j] : v[j] * rstd * ga[j];
        if (mode == 1 && lane == 0) S0[m] = tot;
        if (mode == 1) {
#pragma unroll
            for (int j = 0; j < 4; ++j) *(f32x4*)(of32 + (size_t)m * DM + 4 * lane + 256 * j) = v[j];
        }
        if (mode >= 2) {
#pragma unroll
            for (int j = 0; j < 4; ++j) *(f32x4*)(of32 + (size_t)m * DM + 4 * lane + 256 * j) = y[j];
        }
        if (mode == 2) {
            float s2 = 0.f;
#pragma unroll
            for (int j = 0; j < 4; ++j) s2 += (y[j].x * y[j].x + y[j].y * y[j].y) + (y[j].z * y[j].z + y[j].w * y[j].w);
            const float r2 = 1.0f / sqrtf(wave_sum(s2) * (1.0f / DM) + EPS);
#pragma unroll
            for (int j = 0; j < 4; ++j) y[j] = y[j] * r2 * gb[j];
        }
        if (mode != 3) {
#pragma unroll
            for (int j = 0; j < 4; ++j) { u32x2 w; w.x = cvtpk(y[j].x, y[j].y); w.y = cvtpk(y[j].z, y[j].w); *(u32x2*)(obf + (size_t)m * DM + 4 * lane + 256 * j) = w; }
        }
    }
}

__device__ __forceinline__ void qknorm_phase(const Args& a, int layer, bf16* qkv, int gtid, int gthreads, int lane) {
    const int cpr = layer == 0 ? 256 : 160, ld = layer == 0 ? LD0 : LD1;
    const long total = (long)NTOK * cpr;
    const int l8 = lane & 7;
    for (long idx = gtid; idx < total; idx += gthreads) {
        const int m = (int)(idx / cpr), ch = (int)(idx % cpr);
        int col; const float* g; bool isq;
        if (layer == 0) { col = ch < 128 ? ch * 8 : 1536 + (ch - 128) * 8;
            if (col < 512) { g = inp(a, 9); isq = true; } else if (col < 1024) { g = inp(a, 10); isq = false; } else if (col < 2048) { g = inp(a, 16); isq = true; } else { g = inp(a, 17); isq = false; } }
        else { col = ch * 8; if (col < 1024) { g = inp(a, 21); isq = true; } else { g = inp(a, 22); isq = false; } }
        bf16* p = qkv + (size_t)m * ld + col;
        const u32x4 raw = *(const u32x4*)p;
        float x[8];
#pragma unroll
        for (int j = 0; j < 4; ++j) { x[2 * j] = __uint_as_float(raw[j] << 16); x[2 * j + 1] = __uint_as_float(raw[j] & 0xffff0000u); }
        float ss = 0.f;
#pragma unroll
        for (int j = 0; j < 8; ++j) ss += x[j] * x[j];
        ss += __shfl_xor(ss, 1); ss += __shfl_xor(ss, 2); ss += __shfl_xor(ss, 4);
        const float rstd = 1.0f / sqrtf(ss * (1.0f / 64.0f) + EPS);
        const f32x4 g0 = *(const f32x4*)(g + l8 * 8), g1v = *(const f32x4*)(g + l8 * 8 + 4);
        x[0] *= rstd * g0.x; x[1] *= rstd * g0.y; x[2] *= rstd * g0.z; x[3] *= rstd * g0.w;
        x[4] *= rstd * g1v.x; x[5] *= rstd * g1v.y; x[6] *= rstd * g1v.z; x[7] *= rstd * g1v.w;
        if (layer == 1) {
            const int t = m & (SEQ - 1);
            const float pos = (float)((l8 >> 2) ? (t & 63) : (t >> 6));
            const bool second = (l8 >> 1) & 1;
#pragma unroll
            for (int j = 0; j < 8; ++j) {
                const int i = (l8 & 1) * 8 + j;
                const float invf = __builtin_amdgcn_exp2f(-(float)i * (13.287712379549449f / 16.0f));
                const float ang = pos * invf;
                const float cs = __cosf(ang), sn = __sinf(ang);
                const float other = __shfl_xor(x[j], 2);
                x[j] = second ? (x[j] * cs + other * sn) : (x[j] * cs - other * sn);
            }
        }
        const float sc = isq ? QSCALE : 1.0f;
        u32x4 w; w.x = cvtpk(x[0] * sc, x[1] * sc); w.y = cvtpk(x[2] * sc, x[3] * sc); w.z = cvtpk(x[4] * sc, x[5] * sc); w.w = cvtpk(x[6] * sc, x[7] * sc);
        *(u32x4*)p = w;
    }
}

__device__ __forceinline__ int crow(int r, int hi) { return (r & 3) + 8 * (r >> 2) + 4 * hi; }
__device__ __forceinline__ s16x4 vtr(const LAS unsigned char* p) { return __builtin_bit_cast(s16x4, __builtin_amdgcn_ds_read_tr16_b64_v4i16((LAS v4i16_t*)p)); }
#define MFMA32(a, b, c) __builtin_amdgcn_mfma_f32_32x32x16_bf16((a), (b), (c), 0, 0, 0)

struct ModNone {
    float negM;
    __device__ __forceinline__ void cinit(f32x16& c0, f32x16& c1, int) const {
#pragma unroll
        for (int r = 0; r < 16; ++r) { c0[r] = negM; c1[r] = negM; }
    }
};
struct ModAlibi {
    float negM, slope; int qpos, hi;
    __device__ __forceinline__ void cinit(f32x16& c0, f32x16& c1, int t) const {
        const float base = (float)(qpos - t * 64 - 4 * hi);
#pragma unroll
        for (int r = 0; r < 16; ++r) { const float off = (float)((r & 3) + 8 * (r >> 2));
            c0[r] = negM - slope * fabsf(base - off); c1[r] = negM - slope * fabsf(base - (off + 32.0f)); }
    }
};
struct ModNA {
    const float* rpb_h; float negM; int r, c, cs, rs, lo, hi;
    __device__ __forceinline__ void cinit(f32x16& c0, f32x16& c1, int t) const {
        const int rid = lo + t; const bool rowok = rid >= rs && rid < rs + 8;
        const float* brow = rpb_h + clampi(rid - r + 7, 0, 14) * 31;
#pragma unroll
        for (int q = 0; q < 16; ++q) { const int kc = 4 * hi + (q & 3) + 8 * (q >> 2);
            { const int idx = clampi(kc - c + 15, 0, 30); const float bias = brow[idx] * L2E + negM; c0[q] = (rowok && (unsigned)(kc - cs) < 16u) ? bias : -INFINITY; }
            { const int k2 = kc + 32; const int idx = clampi(k2 - c + 15, 0, 30); const float bias = brow[idx] * L2E + negM; c1[q] = (rowok && (unsigned)(k2 - cs) < 16u) ? bias : -INFINITY; } }
    }
};

template <int DV, bool PIPE, class Mod, int VAR = 0>
__device__ __forceinline__ void attn_loop(LAS unsigned char* lds, const bf16* Kg, const bf16* Vg, int ld, int nt,
                                          const bf16x8 (&qr)[4], f32x16 (&o)[DV / 32], float& l, const Mod& mod, int tid, int lane, int r32, int hi) {
    constexpr int KROW = 144, VROW = DV * 2 + 64, KSLOT = 64 * KROW, VSLOT = 64 * VROW, VBASE = 3 * KSLOT;
    const int lkv = tid >> 3, lch = tid & 7;
    const bf16* kp = Kg + (size_t)lkv * ld + lch * 8;
    const bf16* vp = Vg + (size_t)lkv * ld + lch * 8;
    u32x4 kreg = *(const u32x4*)kp, vreg0 = *(const u32x4*)vp, vreg1 = (u32x4){0u, 0u, 0u, 0u};
    if (DV == 128) vreg1 = *(const u32x4*)(vp + 64);
    LAS unsigned char* kdst = lds + lkv * KROW + lch * 16;
    LAS unsigned char* vdst = lds + VBASE + lkv * VROW + lch * 16;
    const LAS unsigned char* kfr = lds + r32 * KROW + hi * 16;
    const LAS unsigned char* vfr = lds + VBASE + (4 * hi + ((lane & 15) >> 2)) * VROW + (16 * ((lane >> 4) & 1) + 4 * (lane & 3)) * 2;
#define ATT_LOADT(tt) do { const size_t adv_ = (size_t)(tt) * 64 * ld; kreg = *(const u32x4*)(kp + adv_); vreg0 = *(const u32x4*)(vp + adv_); if (DV == 128) vreg1 = *(const u32x4*)(vp + adv_ + 64); } while (0)
#define ATT_STORE(slot) do { *(LAS u32x4*)(kdst + (slot) * KSLOT) = kreg; *(LAS u32x4*)(vdst + (slot) * VSLOT) = vreg0; if (DV == 128) *(LAS u32x4*)(vdst + (slot) * VSLOT + 128) = vreg1; } while (0)
#define ATT_QK(S0, S1, slot) do { _Pragma("unroll") for (int d0 = 0; d0 < 4; ++d0) { \
        const bf16x8 k0_ = *(const LAS bf16x8*)(kfr + (slot) * KSLOT + d0 * 32), k1_ = *(const LAS bf16x8*)(kfr + (slot) * KSLOT + 32 * KROW + d0 * 32); \
        S0 = MFMA32(k0_, qr[d0], S0); S1 = MFMA32(k1_, qr[d0], S1); } } while (0)
    __syncthreads();
    ATT_STORE(0);
    f32x16 s0, s1;
    if (PIPE) {
        __syncthreads();
        ATT_LOADT(nt > 1 ? 1 : 0);
        mod.cinit(s0, s1, 0);
        ATT_QK(s0, s1, 0);
    } else {
        ATT_LOADT(nt > 1 ? 1 : 0);
    }
    int sc = 0, sn = 1, snn = 2;
    for (int t = 0; t < nt; ++t) {
        if (!(VAR & 8)) ATT_STORE(sn);
        __syncthreads();
        if (!(VAR & 8)) { const int tn = t + 2 < nt ? t + 2 : nt - 1; ATT_LOADT(tn); }
        __builtin_amdgcn_sched_barrier(0);
        f32x16 n0, n1;
        if (PIPE) {
            mod.cinit(n0, n1, t + 1);
            if (!(VAR & 4)) ATT_QK(n0, n1, sn);
        } else {
            mod.cinit(s0, s1, t);
            if (!(VAR & 4)) ATT_QK(s0, s1, sc);
        }
        float rs = 0.f;
#pragma unroll
        for (int r = 0; r < 16; ++r) { if (!(VAR & 1)) { s0[r] = __builtin_amdgcn_exp2f(s0[r]); s1[r] = __builtin_amdgcn_exp2f(s1[r]); } rs += s0[r] + s1[r]; }
        l += rs;
        bf16x8 pa[4];
        { u32x4 w;
          w.x = cvtpk(s0[0], s0[1]); w.y = cvtpk(s0[2], s0[3]); w.z = cvtpk(s0[4], s0[5]); w.w = cvtpk(s0[6], s0[7]); pa[0] = __builtin_bit_cast(bf16x8, w);
          w.x = cvtpk(s0[8], s0[9]); w.y = cvtpk(s0[10], s0[11]); w.z = cvtpk(s0[12], s0[13]); w.w = cvtpk(s0[14], s0[15]); pa[1] = __builtin_bit_cast(bf16x8, w);
          w.x = cvtpk(s1[0], s1[1]); w.y = cvtpk(s1[2], s1[3]); w.z = cvtpk(s1[4], s1[5]); w.w = cvtpk(s1[6], s1[7]); pa[2] = __builtin_bit_cast(bf16x8, w);
          w.x = cvtpk(s1[8], s1[9]); w.y = cvtpk(s1[10], s1[11]); w.z = cvtpk(s1[12], s1[13]); w.w = cvtpk(s1[14], s1[15]); pa[3] = __builtin_bit_cast(bf16x8, w); }
        if (!(VAR & 2)) {
#pragma unroll
        for (int db = 0; db < DV / 32; ++db)
#pragma unroll
            for (int c = 0; c < 4; ++c) {
                const s16x4 lo4 = vtr(vfr + sc * VSLOT + (16 * c) * VROW + db * 64), hi4 = vtr(vfr + sc * VSLOT + (16 * c + 8) * VROW + db * 64);
                const bf16x8 vf = (bf16x8){lo4[0], lo4[1], lo4[2], lo4[3], hi4[0], hi4[1], hi4[2], hi4[3]};
                o[db] = MFMA32(vf, pa[c], o[db]);
            }
        } else { o[0][0] += __builtin_bit_cast(float, (int)pa[0][0] + (int)pa[1][1] + (int)pa[2][2] + (int)pa[3][3]); }
        if (PIPE) { s0 = n0; s1 = n1; }
        { const int tmp = sc; sc = sn; sn = snn; snn = tmp; }
    }
#undef ATT_LOADT
#undef ATT_STORE
#undef ATT_QK
}

__device__ __forceinline__ void load_q(bf16x8 (&qr)[4], const bf16* qrow, int hi) {
#pragma unroll
    for (int d0 = 0; d0 < 4; ++d0) qr[d0] = *(const bf16x8*)(qrow + d0 * 16 + hi * 8);
}
__device__ __forceinline__ void store_o32(bf16* dst  , const f32x16& v, int hi) {
#pragma unroll
    for (int g = 0; g < 4; ++g) { u32x2 w; w.x = cvtpk(v[4 * g], v[4 * g + 1]); w.y = cvtpk(v[4 * g + 2], v[4 * g + 3]); *(u32x2*)(dst + 8 * g + 4 * hi) = w; }
}

template <int VAR>
__device__ __forceinline__ void gqa_unit(LAS unsigned char* lds, const bf16* qkv, bf16* O, float negM, int b, int head, int qb, int tid, int wid, int lane) {
    asm volatile("" : "+v"(tid));
    lane = tid & 63; const int r32 = lane & 31, hi = lane >> 5;
    const size_t tok0 = (size_t)b * SEQ, qtok = tok0 + qb * 256 + wid * 32 + r32;
    bf16x8 qr[4]; load_q(qr, qkv + qtok * LD1 + head * 64, hi);
    const bf16* Kg = qkv + tok0 * LD1 + 1024 + (head >> 2) * 64;
    f32x16 o[2]; o[0] = (f32x16){}; o[1] = (f32x16){};
    float l = 0.f;
    ModNone mod; mod.negM = negM;
    attn_loop<64, true, ModNone, VAR>(lds, Kg, Kg + 256, LD1, SEQ / 64, qr, o, l, mod, tid, lane, r32, hi);
    const float inv = 1.0f / (l + __shfl_xor(l, 32));
    bf16* orow = O + qtok * DM + head * 64;
    store_o32(orow, o[0] * inv, hi); store_o32(orow + 32, o[1] * inv, hi);
}

__device__ __forceinline__ void na_unit(LAS unsigned char* lds, const bf16* qkv, bf16* O, const float* rpb, float negM, int b, int h, int g, int tid, int wid, int lane) {
    asm volatile("" : "+v"(tid));
    lane = tid & 63; const int r32 = lane & 31, hi = lane >> 5;
    const int r = 4 * g + (wid >> 1), c = 32 * (wid & 1) + r32;
    const size_t tok0 = (size_t)b * SEQ, qtok = tok0 + r * 64 + c;
    const int lo = clampi(4 * g - 4, 0, 24), hirow = clampi(4 * g - 1, 0, 24) + 7;
    bf16x8 qr[4]; load_q(qr, qkv + qtok * LD0 + 1536 + h * 64, hi);
    const bf16* Kg = qkv + (tok0 + (size_t)lo * 64) * LD0 + 2048 + h * 64;
    f32x16 o[2]; o[0] = (f32x16){}; o[1] = (f32x16){};
    float l = 0.f;
    ModNA mod; mod.negM = negM; mod.rpb_h = rpb + h * 15 * 31; mod.r = r; mod.c = c; mod.cs = clampi(c - 8, 0, 48); mod.rs = clampi(r - 4, 0, 24); mod.lo = lo; mod.hi = hi;
    attn_loop<64, true, ModNA>(lds, Kg, Kg + 512, LD0, hirow - lo + 1, qr, o, l, mod, tid, lane, r32, hi);
    const float inv = 1.0f / (l + __shfl_xor(l, 32));
    bf16* orow = O + qtok * DM + 512 + h * 64;
    store_o32(orow, o[0] * inv, hi); store_o32(orow + 32, o[1] * inv, hi);
}

__device__ __forceinline__ void diff_unit(LAS unsigned char* lds, const bf16* qkv, bf16* O, float* stash  , const float* subg, float lam, float post, float negM, int b, int h, int qb, int tid, int wid, int lane) {
    asm volatile("" : "+v"(tid));
    lane = tid & 63; const int r32 = lane & 31, hi = lane >> 5;
    const int qpos = qb * 256 + wid * 32 + r32;
    const size_t tok0 = (size_t)b * SEQ, qtok = tok0 + qpos;
    ModAlibi mod; mod.negM = negM; mod.slope = __builtin_amdgcn_exp2f(-2.0f * (float)(h + 1)) * L2E; mod.qpos = qpos; mod.hi = hi;
    const bf16* Vg = qkv + tok0 * LD0 + 1024 + h * 128;
#pragma unroll 1
    for (int c = 0; c < 2; ++c) {
        bf16x8 qr[4]; load_q(qr, qkv + qtok * LD0 + h * 128 + c * 64, hi);
        const bf16* Kg = qkv + tok0 * LD0 + 512 + h * 128 + c * 64;
        f32x16 o[4];
#pragma unroll
        for (int db = 0; db < 4; ++db) o[db] = (f32x16){};
        float l = 0.f;
        attn_loop<128, false, ModAlibi>(lds, Kg, Vg, LD0, SEQ / 64, qr, o, l, mod, tid, lane, r32, hi);
        const float coef = (c == 0 ? 1.0f : -lam) / (l + __shfl_xor(l, 32));
        f32x4* st = (f32x4*)(stash + (size_t)tid * 64);
        if (c == 0) {
#pragma unroll
            for (int db = 0; db < 4; ++db)
#pragma unroll
                for (int g = 0; g < 4; ++g) st[db * 4 + g] = (f32x4){o[db][4 * g], o[db][4 * g + 1], o[db][4 * g + 2], o[db][4 * g + 3]} * coef;
        } else {
            float ss = 0.f;
#pragma unroll
            for (int db = 0; db < 4; ++db)
#pragma unroll
                for (int g = 0; g < 4; ++g) { const f32x4 p = st[db * 4 + g];
#pragma unroll
                    for (int e = 0; e < 4; ++e) { o[db][4 * g + e] = p[e] + o[db][4 * g + e] * coef; ss += o[db][4 * g + e] * o[db][4 * g + e]; } }
            ss += __shfl_xor(ss, 32);
            const float rstd = post / sqrtf(ss * (1.0f / 128.0f) + EPS);
            bf16* orow = O + qtok * DM + h * 128;
#pragma unroll
            for (int db = 0; db < 4; ++db) {
                f32x16 v = o[db];
#pragma unroll
                for (int g = 0; g < 4; ++g) { const f32x4 gg = *(const f32x4*)(subg + 32 * db + 8 * g + 4 * hi);
                    v[4 * g] *= rstd * gg.x; v[4 * g + 1] *= rstd * gg.y; v[4 * g + 2] *= rstd * gg.z; v[4 * g + 3] *= rstd * gg.w; }
                store_o32(orow + 32 * db, v, hi);
            }
        }
    }
}

#define RLX_AGENT __ATOMIC_RELAXED, __HIP_MEMORY_SCOPE_AGENT
#define LDS_WAIT() asm volatile("s_waitcnt lgkmcnt(0)" ::: "memory")
#define VM_WAIT() asm volatile("s_waitcnt vmcnt(0)" ::: "memory")
__device__ __forceinline__ unsigned long long rt() { return __builtin_amdgcn_s_memrealtime(); }
#define XB_TMO      128
#define XB_XCNT(j)  (256  + 64 * (j))
#define XB_XSUB(j)  (1280 + 64 * (j))
#define XB_XGEN(j)  (2304 + 64 * (j))
#define XB_TOP      3328
#define XB_TOPGEN   3392
#define XCD_BAR_WORDS 3456
#define XB_SPIN_CAP (1u << 18)

__device__ __forceinline__ unsigned xb_ld(unsigned* p)              { return __hip_atomic_load(p, __ATOMIC_RELAXED, __HIP_MEMORY_SCOPE_AGENT); }
__device__ __forceinline__ unsigned xb_add(unsigned* p, unsigned v) { return __hip_atomic_fetch_add(p, v, __ATOMIC_RELAXED, __HIP_MEMORY_SCOPE_AGENT); }
__device__ __forceinline__ unsigned xb_xcc_id() { return (unsigned)__builtin_amdgcn_s_getreg((3 << 11) | 20) & 0xFu; }
#define XB_SPIN(cond, bar) do { unsigned _sp = 0; while (cond) { __builtin_amdgcn_s_sleep(1); \
    if ((++_sp & 255u) == 0u) { if (xb_ld(&(bar)[XB_TMO])) break; if (_sp > XB_SPIN_CAP) { atomicAdd(&(bar)[XB_TMO], 1u); break; } } } } while (0)

struct XcdBarrier {
    unsigned* bar; unsigned x;
    volatile LAS unsigned* st;
};

__device__ __forceinline__ XcdBarrier xcd_barrier_post(unsigned* bar, volatile LAS unsigned* st) {
    XcdBarrier b; b.bar = bar; b.x = xb_xcc_id(); b.st = st;
    if (threadIdx.x == 0) (void)xb_add(&bar[XB_XCNT(b.x)], 1u);
    return b;
}
__device__ __forceinline__ void xcd_barrier_complete(unsigned* bar, unsigned x, unsigned& nloc, unsigned& nx) {
    const unsigned G = gridDim.x * gridDim.y * gridDim.z;
    unsigned sum, cnt, mine, sp = 0u;
    for (;;) {
        sum = 0u; cnt = 0u; mine = 0u;
#pragma unroll
        for (unsigned j = 0; j < 16; ++j) { const unsigned c = xb_ld(&bar[XB_XCNT(j)]); sum += c; cnt += (c > 0u) ? 1u : 0u; mine = (j == x) ? c : mine; }
        if (sum == G) break;
        __builtin_amdgcn_s_sleep(1);
        if ((++sp & 255u) == 0u) { if (xb_ld(&bar[XB_TMO])) break; if (sp > XB_SPIN_CAP) { atomicAdd(&bar[XB_TMO], 1u); break; } }
    }
    nloc = mine > 0u ? mine : 1u; nx = cnt > 0u ? cnt : 1u;
}

__device__ __forceinline__ void xcd_barrier(const XcdBarrier& b) {
    asm volatile("s_waitcnt vmcnt(0)" ::: "memory");
    __syncthreads();
    if (threadIdx.x == 0) {
        unsigned* bar = b.bar;
        __builtin_amdgcn_s_waitcnt(0);
        unsigned nloc = b.st[0], nx = b.st[1];
        if (nloc == 0u) { xcd_barrier_complete(bar, b.x, nloc, nx); b.st[0] = nloc; b.st[1] = nx; }
        const unsigned old = xb_add(&bar[XB_XSUB(b.x)], 1u);
        const unsigned gen = old / nloc;
        if (old + 1u == (gen + 1u) * nloc) {
            __builtin_amdgcn_fence(__ATOMIC_RELEASE, "agent");
            asm volatile("s_waitcnt vmcnt(0)" ::: "memory");
            const unsigned og = xb_add(&bar[XB_TOP], 1u);
            const unsigned tg = og / nx;
            if (og + 1u == (tg + 1u) * nx) xb_add(&bar[XB_TOPGEN], 1u);
            else XB_SPIN(xb_ld(&bar[XB_TOPGEN]) == tg, bar);
            __builtin_amdgcn_fence(__ATOMIC_ACQUIRE, "agent");
            xb_add(&bar[XB_XGEN(b.x)], 1u);
            asm volatile("s_waitcnt vmcnt(0)" ::: "memory");
        } else {
            XB_SPIN(xb_ld(&bar[XB_XGEN(b.x)]) == gen, bar);
            __builtin_amdgcn_fence(__ATOMIC_ACQUIRE, "agent");
            asm volatile("s_waitcnt vmcnt(0)" ::: "memory");
        }
    }
    __syncthreads();
}

__global__ void __launch_bounds__(NTHREADS, 2) trunk_fwd(Args a) {
    extern __shared__ __attribute__((aligned(16))) unsigned char lds_raw[];
    LAS unsigned char* lds = (LAS unsigned char*)lds_raw;
#define G (kargs()->grid)
#define bid (opaque_bid())
#define gw (bid * NWAVES + wave)
#define ngw (G * NWAVES)
#define X (kargs()->out)
#define XN ((bf16*)(WSP + WS_XN))
#define BIG ((bf16*)(WSP + WS_BIG))
#define SS(k) ((float*)(WSP + WS_S) + (size_t)(k) * NTOK)

    volatile LAS unsigned* bst = (volatile LAS unsigned*)(lds + 131072);
    if (threadIdx.x < 2) bst[threadIdx.x] = 0u;
    __syncthreads();
    XcdBarrier xbar = xcd_barrier_post((unsigned*)(WSP + WS_CTL) + kargs()->li * XCD_BAR_WORDS, bst);
    for (int ph = kargs()->lo; ph < kargs()->hi; ++ph) {
        int tid_ = threadIdx.x; asm volatile("" : "+v"(tid_));
        const int tid = tid_, lane = tid & 63, wave = __builtin_amdgcn_readfirstlane(tid >> 6);
        if (ph == 0) {
            convert_weights(a, lds, gw, ngw, wave, lane);
            { float* Sz = SS(1); for (int i = bid * NTHREADS + tid; i < 7 * NTOK; i += G * NTHREADS) Sz[i] = 0.f; }
            norm_phase(inp(a, 0), inp(a, 1), nullptr, nullptr, X, XN, 1, gw, ngw, lane, SS(0));
        } else if (ph == 15) {
            norm_phase(X, nullptr, inp(a, 27) + DM, nullptr, X, nullptr, 3, gw, ngw, lane);
        } else {
            const int L = (ph - 1) / 7, s = (ph - 1) % 7;
            if (s == 0 || s == 5) {
                const int i = 2 * L + (s == 5);
                const bf16* A = (s == 5) ? (const bf16*)(WSP + WS_XB2) : XN;
                const int sai = (s == 5) ? 2 + 4 * L : (L == 0 ? 0 : 3), sbi = (s == 0 && L == 1) ? 4 : -1;
                pg8::Gemm g{A, (const bf16*)(WSP + WS_FFN + (size_t)i * SZ_FFN), NTOK, 2 * DFF, DM};
                pg8::StaticOrder S; S.init(NTOK, 2 * DFF, G, bid);
                pg8::EpiSwiglu2 E{sai, sbi};
                pg8::gemm_phase<pg8::EpiSwiglu2, pg8::StaticOrder, true, true>(lds, g, S, E);
            } else if (s == 1 || s == 6) {
                const int i = 2 * L + (s == 6);
                pg8::Gemm g{BIG, (const bf16*)(WSP + WS_FFN + (size_t)i * SZ_FFN + SZ_GU), NTOK, DM, DFF};
                pg8::StaticOrder S; S.init(NTOK, DM, G, bid);
                pg8::EpiRes2 E; E.alpha = 0.5f * (float)kargs()->ascale; E.s2i = -1; E.sini = -1; E.gsel = 0;
                if (s == 1) { E.xbsel = 1; E.s1i = 1 + 4 * L; if (L == 1) { E.sini = 3; E.gsel = 1; } }
                else if (L == 0) { E.xbsel = 1; E.s1i = 3; E.s2i = 4; E.gsel = 2; }
                else { E.xbsel = 0; E.s1i = 7; }
                pg8::gemm_phase<pg8::EpiRes2, pg8::StaticOrder, true, true>(lds, g, S, E);
            } else if (s == 4) {
                pg8::Gemm g{XN, (const bf16*)(WSP + (L == 0 ? WS_ABOUT : WS_COUT)), NTOK, DM, DM};
                pg8::StaticOrder S; S.init(NTOK, DM, G, bid);
                pg8::EpiRes2 E; E.alpha = 1.0f * (float)kargs()->ascale; E.s1i = 2 + 4 * L; E.s2i = -1; E.sini = -1; E.xbsel = 2; E.gsel = 0;
                pg8::gemm_phase<pg8::EpiRes2, pg8::StaticOrder, true, true>(lds, g, S, E);
            } else if (s == 2 && L == 0) {
                pg8::Gemm g{XN, (const bf16*)(WSP + WS_ABIN), NTOK, LD0, DM};
                pg8::StaticOrder S; S.init(NTOK, LD0, G, bid);
                pg8::EpiQKV E{LD0, 1, 0};
                pg8::gemm_phase<pg8::EpiQKV, pg8::StaticOrder, true, true>(lds, g, S, E);
            } else if (s == 2) {
                pg8::Gemm g{XN, (const bf16*)(WSP + WS_CIN), NTOK, LD1, DM};
                pg8::StaticOrder S; S.init(NTOK, LD1, G, bid);
                pg8::EpiQKV E{LD1, 5, 1};
                pg8::gemm_phase<pg8::EpiQKV, pg8::StaticOrder, true, true>(lds, g, S, E);
            } else {
                if (L == 0) {
                    const float d1 = wave_sum(inp(a, 11)[lane] * inp(a, 12)[lane]), d2 = wave_sum(inp(a, 13)[lane] * inp(a, 14)[lane]);
                    const float lambda_init = 0.2f;
                    const float lam = uni(__expf(d1) - __expf(d2) + lambda_init);
                    const float negMa = uni(-(64.0f * QSCALE * 1.01f) * wave_max(fabsf(inp(a, 9)[lane])) * wave_max(fabsf(inp(a, 10)[lane])));
                    float rmax = 0.f;
                    for (int i = lane; i < 8 * 15 * 31; i += 64) rmax = fmaxf(rmax, inp(a, 18)[i]);
                    const float negMb = uni(-(64.0f * QSCALE * 1.01f) * wave_max(fabsf(inp(a, 16)[lane])) * wave_max(fabsf(inp(a, 17)[lane])) - wave_max(rmax) * L2E);
                    for (int u = bid; u < 1536 + 3072; u += G) {
                        if (u < 1536) {
#ifndef NO_DIFF
 diff_unit(lds, BIG, XN, (float*)(WSP + WS_STASH) + (size_t)bid * 64 * NTHREADS, inp(a, 15), lam, 1.0f - lambda_init, negMa, u >> 5, (u >> 3) & 3, u & 7, tid, wave, lane);
#endif
 }
                        else { const int v = u - 1536;
#ifndef NO_NA
 na_unit(lds, BIG, XN, inp(a, 18), negMb, v >> 6, (v >> 3) & 7, v & 7, tid, wave, lane);
#endif
 }
                    }
                } else {
                    const float negMc = uni(-(64.0f * QSCALE * 1.01f) * wave_max(fabsf(inp(a, 21)[lane])) * wave_max(fabsf(inp(a, 22)[lane])));
                    for (int u = bid; u < NBATCH * 16 * 8; u += G) {
#ifndef NO_GQA
 gqa_unit<0>(lds, BIG, XN, negMc, u >> 7, (u >> 3) & 15, u & 7, tid, wave, lane);
#endif
 }
#ifdef PROBE_VAR
                    for (int u = bid; u < NBATCH * 16 * 8; u += G) gqa_unit<PROBE_VAR>(lds, BIG, BIG + (size_t)NTOK * LD1, negMc, u >> 7, (u >> 3) & 15, u & 7, tid, wave, lane);
#endif
                }
            }
        }
        if (ph + 1 < kargs()->hi) { if (ph == kargs()->lo) cg::this_grid().sync(); else xcd_barrier(xbar); }
#ifdef PROBE_SYNC
        if (ph == 14) { for (int i_ = 0; i_ < 40; ++i_) xcd_barrier(xbar); }
#endif
    }
}

#undef G
#undef bid
#undef gw
#undef ngw
#undef X
#undef XN
#undef BIG
#undef SS
#ifndef N_LAUNCH_MODE
#define N_LAUNCH_MODE 0
#endif
extern "C" void kernel_launch(void* const* d_in, const int* in_sizes, int n_in, void* d_out, int out_size, void* d_ws, size_t ws_size, hipStream_t stream) {
    static int grid = 0;
    if (grid == 0) {
        if (n_in != 28 || out_size != NTOK * DM || ws_size < WS_END) { fprintf(stderr, "kernel_launch: unexpected shapes (n_in %d out %d ws %zu)\n", n_in, out_size, ws_size); grid = -1; return; }
        int dev = 0, cus = 0, per_cu = 0;
        if (hipGetDevice(&dev) != hipSuccess || hipDeviceGetAttribute(&cus, hipDeviceAttributeMultiprocessorCount, dev) != hipSuccess) { grid = -1; return; }
        if (hipFuncSetAttribute((const void*)trunk_fwd, hipFuncAttributeMaxDynamicSharedMemorySize, LDS_BYTES) != hipSuccess) { fprintf(stderr, "kernel_launch: hipFuncSetAttribute failed\n"); grid = -1; return; }
        if (hipOccupancyMaxActiveBlocksPerMultiprocessor(&per_cu, (const void*)trunk_fwd, NTHREADS, LDS_BYTES) != hipSuccess || per_cu < 1) { fprintf(stderr, "kernel_launch: occupancy query says %d\n", per_cu); per_cu = 1; }
        (void)hipGetLastError();
        grid = cus * 1;
    }
    if (grid < 0) return;
    if (hipMemsetAsync((char*)d_ws + WS_CTL, 0, CTL_BYTES, stream) != hipSuccess) { fprintf(stderr, "kernel_launch: memset failed\n"); return; }
    Args a{};
    for (int i = 0; i < 28; ++i) a.in[i] = (const float*)d_in[i];
    a.out = (float*)d_out; a.ws = (unsigned char*)d_ws; a.grid = grid; a.ascale = 1;
#if N_LAUNCH_MODE == 1
    for (int ph = 0; ph < NPHASES; ++ph) { a.lo = ph; a.hi = ph + 1; hipLaunchKernelGGL(trunk_fwd, dim3(grid), dim3(NTHREADS), LDS_BYTES, stream, a); }
#elif defined(PROBE_PH)
    const int cuts[4][2] = {{0, PROBE_PH + 1}, {PROBE_PH, PROBE_PH + 1}, {PROBE_PH + 1, NPHASES}, {0, 0}};
    for (int li = 0; li < 3; ++li) { a.lo = cuts[li][0]; a.hi = cuts[li][1]; a.ascale = (li == 1) ? 0 : 1; a.li = li; void* args[] = {&a};
        hipError_t e = hipLaunchCooperativeKernel((const void*)trunk_fwd, dim3(grid), dim3(NTHREADS), args, LDS_BYTES, stream);
        if (e != hipSuccess) fprintf(stderr, "kernel_launch: cooperative launch failed: %s (grid %d)\n", hipGetErrorString(e), grid); }
#else
    a.lo = 0; a.hi = NPHASES;
    void* args[] = {&a};
    hipError_t e = hipLaunchCooperativeKernel((const void*)trunk_fwd, dim3(grid), dim3(NTHREADS), args, LDS_BYTES, stream);
    if (e != hipSuccess) fprintf(stderr, "kernel_launch: cooperative launch failed: %s (grid %d)\n", hipGetErrorString(e), grid);
#endif
}
```

```cpp
#include <hip/hip_runtime.h>
#include <cstdio>
#include <cstdint>
#include <cmath>

#include <hip/hip_cooperative_groups.h>
namespace cg = cooperative_groups;

#define LAS __attribute__((address_space(3)))
typedef unsigned short bf16;
typedef float f32x4 __attribute__((ext_vector_type(4)));
typedef float f32x16 __attribute__((ext_vector_type(16)));
typedef short bf16x8 __attribute__((ext_vector_type(8)));
typedef short s16x4 __attribute__((ext_vector_type(4)));
typedef short v4i16_t __attribute__((ext_vector_type(4)));
typedef unsigned u32x4 __attribute__((ext_vector_type(4)));
typedef unsigned u32x2 __attribute__((ext_vector_type(2)));
typedef float f32x2_t __attribute__((ext_vector_type(2)));
typedef __bf16 bf16x2_t __attribute__((ext_vector_type(2)));

constexpr int NTOK = 98304, NPROMPT = 65536, DM = 1024, DFF = 2816, SEQ = 2048, NBATCH = 48;
constexpr int LD0 = 3072, LD1 = 1536;
constexpr float EPS = 1e-6f, L2E = 1.4426950408889634f;
constexpr float QSCALE = 0.125f * L2E;
constexpr int NWAVES = 8, NTHREADS = 512;
constexpr int LDS_BYTES = 147456;
constexpr int NPHASES = 16;

constexpr size_t MiB = 1u << 20;
constexpr size_t SZ_GU = (size_t)2 * DFF * DM * 2, SZ_D = (size_t)DM * DFF * 2, SZ_FFN = SZ_GU + SZ_D;
constexpr size_t WS_FFN = 0;
constexpr size_t WS_ABIN = 4 * SZ_FFN, WS_ABOUT = WS_ABIN + (size_t)LD0 * DM * 2, WS_CIN = WS_ABOUT + (size_t)DM * DM * 2, WS_COUT = WS_CIN + (size_t)LD1 * DM * 2;
constexpr size_t WS_WEND = WS_COUT + (size_t)DM * DM * 2;
constexpr size_t WS_XN = 96 * MiB;
constexpr size_t WS_BIG = 288 * MiB;
constexpr size_t WS_S = 80 * MiB;
constexpr size_t WS_CTL = 84 * MiB, CTL_BYTES = 65536;
constexpr size_t WS_XB2 = 832 * MiB;
constexpr size_t WS_STASH = 864 * MiB;
constexpr size_t WS_END = 1024 * MiB;
static_assert(WS_WEND <= WS_S && WS_S + 8 * (size_t)NTOK * 4 <= WS_XN && WS_BIG + (size_t)NTOK * DFF * 2 <= WS_XB2 && WS_XB2 + (size_t)NTOK * DM * 2 <= WS_END && WS_STASH + 256 * 64 * 512 * 4 <= WS_END && WS_XN + (size_t)NTOK * DM * 2 <= WS_BIG && WS_BIG + (size_t)NTOK * LD0 * 2 <= WS_END, "d_ws map");

struct Args { const float* in[28]; float* out; unsigned char* ws; int lo, hi, grid, ascale, li, pad2; };
__device__ __forceinline__ int opaque_bid() { int b = blockIdx.x; asm volatile("" : "+s"(b)); return b; }
typedef const __attribute__((address_space(4))) Args* KArgs;
__device__ __forceinline__ KArgs kargs() { KArgs p = (KArgs)__builtin_amdgcn_kernarg_segment_ptr(); asm volatile("" : "+s"(p)); return p; }
#define inp(a_, i_) (kargs()->in[(i_)])
#define WSP (kargs()->ws)
namespace pg8 {
#define PG8_LAS __attribute__((address_space(3)))
typedef unsigned short bf16_t;
typedef short bf16x8 __attribute__((ext_vector_type(8)));
typedef float f32x4 __attribute__((ext_vector_type(4)));
typedef unsigned u32x4 __attribute__((ext_vector_type(4)));
constexpr int BM = 256, BK = 64, HALF = 128, HTB = HALF * BK * 2  , STAGE_BYTES = 8 * HTB, NXCD = 8, WGM = 8;

__host__ __device__ __forceinline__ int lds_byte(int r, int c) { const int st = (r >> 4) * 2 + (c >> 5), rr = r & 15, cc = c & 31, ob = rr * 64 + cc * 2; return st * 1024 + (ob ^ (((ob >> 9) & 1) << 5)); }
__host__ __device__ __forceinline__ void stage_rc(int b, int& R, int& C) { const int st = b / 1024, sb = b % 1024, swz = sb ^ (((sb >> 9) & 1) << 5); R = (st >> 1) * 16 + swz / 64; C = (st & 1) * 32 + (swz % 64) / 2; }
__host__ __device__ __forceinline__ int perm32(int rho) { const int n = rho >> 4, i = rho & 15; return 8 * (i >> 2) + 4 * n + (i & 3); }

struct Unit { int pm, pn; };
struct Gemm { const bf16_t* A; const bf16_t* Bt; int M, N, K; };

struct StaticOrder {
    int nM, nN, nwg, G, c;
    __host__ __device__ void init(int M, int N, int G_, int c_) { nM = M / BM; nN = N / BM; nwg = nM * nN; G = G_; c = c_; }
    __host__ __device__ bool next(int i, Unit& u) const {
        const long L = (long)i * G + c; if (L >= nwg) return false;
        int wgid = (int)L; { const int q = nwg / NXCD, r = nwg % NXCD, xcd = wgid % NXCD, off = wgid / NXCD; wgid = (xcd < r ? xcd * (q + 1) : r * (q + 1) + (xcd - r) * q) + off; }
        const int nig = WGM * nN, gid = wgid / nig, fm = gid * WGM, gsz = (nM - fm) < WGM ? (nM - fm) : WGM;
        u.pm = fm + ((wgid % nig) % gsz); u.pn = (wgid % nig) / gsz; return true;
    }
    __device__ __forceinline__ void a_ready(const Unit&) const {}
    __device__ __forceinline__ void done(const Unit&) const {}
};

__device__ __forceinline__ unsigned cvt_pk_bf16(float lo, float hi) { unsigned r; asm volatile("v_cvt_pk_bf16_f32 %0, %1, %2" : "=v"(r) : "v"(lo), "v"(hi)); return r; }
typedef float f32x2 __attribute__((ext_vector_type(2)));
__device__ __forceinline__ f32x2 gelu_pk(f32x2 v) {
    const f32x2 av = __builtin_elementwise_abs(v), d = av * 0.2316418882f + 1.0f;
    f32x2 t; t.x = __builtin_amdgcn_rcpf(d.x); t.y = __builtin_amdgcn_rcpf(d.y);
    f32x2 q = t * 0.5307027145f + (-0.7265760135f); q = q * t + 0.7107068705f; q = q * t + (-0.142248368f); q = q * t + 0.127414796f; q = q * t;
    const f32x2 s = (v * v) * (-0.72134752044f);
    f32x2 e; e.x = __builtin_amdgcn_exp2f(s.x); e.y = __builtin_amdgcn_exp2f(s.y);
    const f32x2 m = v * (q * e), r = v - m;
    f32x2 o; o.x = v.x < 0.f ? m.x : r.x; o.y = v.y < 0.f ? m.y : r.y; return o;
}

template <int ACT  > struct EpiBf16 {
    static constexpr bool PERM = true, AFTER_DRAIN = false; static_assert(ACT == 0 || ACT == 1, "EpiBf16: ACT is 0 (none) or 1 (gelu_pk)");
    bf16_t* O; int ldc; const float* bias; int split_cols; size_t split_stride; float scale0;
    __device__ __forceinline__ void operator()(const f32x4 (&acc)[2][2][4][2], const Unit& u, int wr, int wc, int fr, int fq) const {
        const int row0 = u.pm * BM + wr * 64 + fr; int colt = u.pn * BM; bf16_t* base = O;
        float sc = 1.f; if (split_cols) { const int t = colt / split_cols; base += (size_t)t * split_stride; colt -= t * split_cols; if (t == 0) sc = scale0; }
        const int col0 = colt + wc * 32 + 8 * fq, bcol0 = u.pn * BM + wc * 32 + 8 * fq;
        f32x4 bv[2][2];
#pragma unroll
        for (int bj = 0; bj < 2; ++bj)
#pragma unroll
            for (int n = 0; n < 2; ++n) bv[bj][n] = bias ? *(const f32x4*)(bias + bcol0 + bj * HALF + 4 * n) : (f32x4){0.f, 0.f, 0.f, 0.f};
#pragma unroll
        for (int ai = 0; ai < 2; ++ai)
#pragma unroll
            for (int m = 0; m < 4; ++m) { bf16_t* rowp = base + (size_t)(row0 + ai * HALF + m * 16) * ldc + col0;
#pragma unroll
                for (int bj = 0; bj < 2; ++bj) { f32x4 v0 = acc[ai][bj][m][0] + bv[bj][0], v1 = acc[ai][bj][m][1] + bv[bj][1];
                    if (ACT == 1) { f32x2 a = gelu_pk((f32x2){v0[0], v0[1]}), b = gelu_pk((f32x2){v0[2], v0[3]}), c = gelu_pk((f32x2){v1[0], v1[1]}), d = gelu_pk((f32x2){v1[2], v1[3]});
                        v0 = (f32x4){a.x, a.y, b.x, b.y}; v1 = (f32x4){c.x, c.y, d.x, d.y}; }
                    v0 = v0 * sc; v1 = v1 * sc; u32x4 w; w.x = cvt_pk_bf16(v0[0], v0[1]); w.y = cvt_pk_bf16(v0[2], v0[3]); w.z = cvt_pk_bf16(v1[0], v1[1]); w.w = cvt_pk_bf16(v1[2], v1[3]);
                    *(u32x4*)(rowp + bj * HALF) = w; } }
    }
};

struct EpiSwiglu {
    static constexpr bool PERM = true, AFTER_DRAIN = false;
    bf16_t* H; int ldh;
    __device__ __forceinline__ void operator()(const f32x4 (&acc)[2][2][4][2], const Unit& u, int wr, int wc, int fr, int fq) const {
        const int row0 = u.pm * BM + wr * 64 + fr; const int col0 = u.pn * HALF + wc * 32 + 8 * fq;
#pragma unroll
        for (int ai = 0; ai < 2; ++ai)
#pragma unroll
            for (int m = 0; m < 4; ++m) { bf16_t* rowp = H + (size_t)(row0 + ai * HALF + m * 16) * ldh + col0;
                float hv[8];
#pragma unroll
                for (int n = 0; n < 2; ++n)
#pragma unroll
                    for (int e = 0; e < 4; ++e) { const float g = acc[ai][0][m][n][e], up = acc[ai][1][m][n][e];
                        const float sg = __builtin_amdgcn_rcpf(1.0f + __builtin_amdgcn_exp2f(-1.4426950408889634f * g));
                        hv[n * 4 + e] = g * sg * up; }
                u32x4 w; w.x = cvt_pk_bf16(hv[0], hv[1]); w.y = cvt_pk_bf16(hv[2], hv[3]); w.z = cvt_pk_bf16(hv[4], hv[5]); w.w = cvt_pk_bf16(hv[6], hv[7]);
                *(u32x4*)rowp = w; }
    }
};
struct EpiRes {
    static constexpr bool PERM = true, AFTER_DRAIN = false;
    float* X; int ldc; float alpha;
    __device__ __forceinline__ void operator()(const f32x4 (&acc)[2][2][4][2], const Unit& u, int wr, int wc, int fr, int fq) const {
        const int row0 = u.pm * BM + wr * 64 + fr; const int col0 = u.pn * BM + wc * 32 + 8 * fq;
#pragma unroll
        for (int ai = 0; ai < 2; ++ai)
#pragma unroll
            for (int m = 0; m < 4; ++m) { float* rowp = X + (size_t)(row0 + ai * HALF + m * 16) * ldc + col0;
#pragma unroll
                for (int bj = 0; bj < 2; ++bj) { f32x4 a = *(const f32x4*)(rowp + bj * HALF), b = *(const f32x4*)(rowp + bj * HALF + 4);
                    a += acc[ai][bj][m][0] * alpha; b += acc[ai][bj][m][1] * alpha;
                    *(f32x4*)(rowp + bj * HALF) = a; *(f32x4*)(rowp + bj * HALF + 4) = b; } }
    }
};

__device__ __forceinline__ float* SSp(int k) { return (float*)(kargs()->ws + WS_S) + (size_t)k * NTOK; }
__device__ __forceinline__ float row_rstd(const float* Sa, const float* Sb, int row) {
    float r = 1.0f / sqrtf(Sa[row] * (1.0f / 1024.0f) + 1e-6f);
    if (Sb) r *= 1.0f / sqrtf(r * r * Sb[row] * (1.0f / 1024.0f) + 1e-6f);
    return r;
}
struct EpiSwiglu2 {
    static constexpr bool PERM = true, AFTER_DRAIN = false;
    int sai, sbi;
    __device__ __forceinline__ void operator()(const f32x4 (&acc)[2][2][4][2], const Unit& u, int wr, int wc, int fr, int fq) const {
        asm volatile("" : "+v"(fr), "+v"(fq));
        const int row0 = u.pm * BM + wr * 64 + fr; const int col0 = u.pn * HALF + wc * 32 + 8 * fq;
        bf16_t* H = (bf16_t*)(kargs()->ws + WS_BIG); const int ldh = DFF; const float* Sa = SSp(sai); const float* Sb = sbi >= 0 ? SSp(sbi) : nullptr;
#pragma unroll
        for (int ai = 0; ai < 2; ++ai)
#pragma unroll
            for (int m = 0; m < 4; ++m) { const int row = row0 + ai * HALF + m * 16; bf16_t* rowp = H + (size_t)row * ldh + col0;
                const float rs = row_rstd(Sa, Sb, row);
                float hv[8];
#pragma unroll
                for (int n = 0; n < 2; ++n)
#pragma unroll
                    for (int e = 0; e < 4; ++e) { const float g = acc[ai][0][m][n][e] * rs, up = acc[ai][1][m][n][e] * rs;
                        const float sg = __builtin_amdgcn_rcpf(1.0f + __builtin_amdgcn_exp2f(-1.4426950408889634f * g));
                        hv[n * 4 + e] = g * sg * up; }
                u32x4 w; w.x = cvt_pk_bf16(hv[0], hv[1]); w.y = cvt_pk_bf16(hv[2], hv[3]); w.z = cvt_pk_bf16(hv[4], hv[5]); w.w = cvt_pk_bf16(hv[6], hv[7]);
                *(u32x4*)rowp = w; }
    }
};
struct EpiRow {
    static constexpr bool PERM = true, AFTER_DRAIN = false;
    bf16_t* O; int ldc; const float* Sa;
    __device__ __forceinline__ void operator()(const f32x4 (&acc)[2][2][4][2], const Unit& u, int wr, int wc, int fr, int fq) const {
        const int row0 = u.pm * BM + wr * 64 + fr; const int col0 = u.pn * BM + wc * 32 + 8 * fq;
#pragma unroll
        for (int ai = 0; ai < 2; ++ai)
#pragma unroll
            for (int m = 0; m < 4; ++m) { const int row = row0 + ai * HALF + m * 16; bf16_t* rowp = O + (size_t)row * ldc + col0;
                const float rs = row_rstd(Sa, nullptr, row);
#pragma unroll
                for (int bj = 0; bj < 2; ++bj) { const f32x4 v0 = acc[ai][bj][m][0] * rs, v1 = acc[ai][bj][m][1] * rs;
                    u32x4 w; w.x = cvt_pk_bf16(v0[0], v0[1]); w.y = cvt_pk_bf16(v0[2], v0[3]); w.z = cvt_pk_bf16(v1[0], v1[1]); w.w = cvt_pk_bf16(v1[2], v1[3]);
                    *(u32x4*)(rowp + bj * HALF) = w; } }
    }
};
struct EpiRes2 {
    static constexpr bool PERM = true, AFTER_DRAIN = false;
    int s1i, s2i, sini, xbsel, gsel; float alpha;
    __device__ __forceinline__ void operator()(const f32x4 (&acc)[2][2][4][2], const Unit& u, int wr, int wc, int fr, int fq) const {
        asm volatile("" : "+v"(fr), "+v"(fq));
        const int row0 = u.pm * BM + wr * 64 + fr; const int col0 = u.pn * BM + wc * 32 + 8 * fq;
        unsigned char* ws_ = kargs()->ws; float* xr = kargs()->out;
        bf16_t* xb = xbsel == 0 ? nullptr : (bf16_t*)(ws_ + (xbsel == 1 ? WS_XN : WS_XB2));
        float* S1 = SSp(s1i); float* S2 = s2i >= 0 ? SSp(s2i) : nullptr; const float* Sin = sini >= 0 ? SSp(sini) : nullptr;
        const float* gfin = kargs()->in[27]; const float* gin = gsel == 1 ? gfin : nullptr; const float* gout = gsel == 2 ? gfin : nullptr;
        f32x4 gi[2][2], go[2][2];
#pragma unroll
        for (int bj = 0; bj < 2; ++bj)
#pragma unroll
            for (int n = 0; n < 2; ++n) { gi[bj][n] = gin ? *(const f32x4*)(gin + col0 + bj * HALF + 4 * n) : (f32x4){1.f, 1.f, 1.f, 1.f};
                                          go[bj][n] = gout ? *(const f32x4*)(gout + col0 + bj * HALF + 4 * n) : (f32x4){1.f, 1.f, 1.f, 1.f}; }
#pragma unroll
        for (int ai = 0; ai < 2; ++ai)
#pragma unroll
            for (int m = 0; m < 4; ++m) { const int row = row0 + ai * HALF + m * 16; float* rowp = xr + (size_t)row * 1024 + col0;
                const float rsc = gin ? 1.0f / sqrtf(Sin[row] * (1.0f / 1024.0f) + 1e-6f) : 1.0f;
                float s1 = 0.f, s2 = 0.f;
#pragma unroll
                for (int bj = 0; bj < 2; ++bj) { f32x4 a = *(const f32x4*)(rowp + bj * HALF), b = *(const f32x4*)(rowp + bj * HALF + 4);
                    a = a * (gi[bj][0] * rsc) + acc[ai][bj][m][0] * alpha; b = b * (gi[bj][1] * rsc) + acc[ai][bj][m][1] * alpha;
                    *(f32x4*)(rowp + bj * HALF) = a; *(f32x4*)(rowp + bj * HALF + 4) = b;
                    s1 += (a[0] * a[0] + a[1] * a[1]) + (a[2] * a[2] + a[3] * a[3]) + (b[0] * b[0] + b[1] * b[1]) + (b[2] * b[2] + b[3] * b[3]);
                    a = a * go[bj][0]; b = b * go[bj][1];
                    s2 += (a[0] * a[0] + a[1] * a[1]) + (a[2] * a[2] + a[3] * a[3]) + (b[0] * b[0] + b[1] * b[1]) + (b[2] * b[2] + b[3] * b[3]);
                    if (xb) { u32x4 w; w.x = cvt_pk_bf16(a[0], a[1]); w.y = cvt_pk_bf16(a[2], a[3]); w.z = cvt_pk_bf16(b[0], b[1]); w.w = cvt_pk_bf16(b[2], b[3]);
                        *(u32x4*)(xb + (size_t)row * 1024 + col0 + bj * HALF) = w; } }
                s1 += __shfl_xor(s1, 16); s1 += __shfl_xor(s1, 32); s2 += __shfl_xor(s2, 16); s2 += __shfl_xor(s2, 32);
                if (fq == 0) { __hip_atomic_fetch_add(S1 + row, s1, __ATOMIC_RELAXED, __HIP_MEMORY_SCOPE_AGENT);
                               if (S2) __hip_atomic_fetch_add(S2 + row, s2, __ATOMIC_RELAXED, __HIP_MEMORY_SCOPE_AGENT); } }
    }
};
struct EpiQKV {
    static constexpr bool PERM = true, AFTER_DRAIN = false;
    int ldc, sai, layer;
    __device__ __forceinline__ void operator()(const f32x4 (&acc)[2][2][4][2], const Unit& u, int wr, int wc, int fr, int fq) const {
        asm volatile("" : "+v"(fr), "+v"(fq));
        const float QS = 0.125f * 1.4426950408889634f;
        bf16_t* O = (bf16_t*)(kargs()->ws + WS_BIG); const float* Sa = SSp(sai);
        const int pn = u.pn; int kind; int gi_; float sc;
        if (layer == 0) { const int reg = pn >> 1;
            kind = (reg == 2 || reg == 5) ? 0 : 1; gi_ = reg == 0 ? 9 : (reg == 1 ? 10 : (reg == 3 ? 16 : 17)); sc = (reg == 0 || reg == 3) ? QS : 1.0f; }
        else { kind = pn < 5 ? 2 : 0; gi_ = pn < 4 ? 21 : 22; sc = pn < 4 ? QS : 1.0f; }
        const float* gp = kargs()->in[gi_];
        const int row0 = u.pm * BM + wr * 64 + fr; const int col0 = pn * BM + wc * 64 + 8 * fq;
        f32x4 gg[2][2]; float invf[2][4];
#pragma unroll
        for (int bj = 0; bj < 2; ++bj)
#pragma unroll
            for (int n = 0; n < 2; ++n) gg[bj][n] = kind ? *(const f32x4*)(gp + 32 * bj + 8 * fq + 4 * n) * sc : (f32x4){1.f, 1.f, 1.f, 1.f};
#pragma unroll
        for (int n = 0; n < 2; ++n)
#pragma unroll
            for (int e = 0; e < 4; ++e) invf[n][e] = __builtin_amdgcn_exp2f(-(float)(8 * (fq & 1) + 4 * n + e) * (13.287712379549449f / 16.0f));
#pragma unroll
        for (int ai = 0; ai < 2; ++ai)
#pragma unroll
            for (int m = 0; m < 4; ++m) { const int row = row0 + ai * HALF + m * 16; bf16_t* rowp = O + (size_t)row * ldc + col0;
                const float rs = row_rstd(Sa, nullptr, row);
                f32x4 v[2][2];
#pragma unroll
                for (int bj = 0; bj < 2; ++bj)
#pragma unroll
                    for (int n = 0; n < 2; ++n) v[bj][n] = acc[ai][bj][m][n] * rs;
                if (kind) {
                    float ss = 0.f;
#pragma unroll
                    for (int bj = 0; bj < 2; ++bj)
#pragma unroll
                        for (int n = 0; n < 2; ++n) ss += (v[bj][n][0] * v[bj][n][0] + v[bj][n][1] * v[bj][n][1]) + (v[bj][n][2] * v[bj][n][2] + v[bj][n][3] * v[bj][n][3]);
                    ss += __shfl_xor(ss, 16); ss += __shfl_xor(ss, 32);
                    const float r = 1.0f / sqrtf(ss * (1.0f / 64.0f) + 1e-6f);
#pragma unroll
                    for (int bj = 0; bj < 2; ++bj)
#pragma unroll
                        for (int n = 0; n < 2; ++n) v[bj][n] = v[bj][n] * gg[bj][n] * r;
                    if (kind == 2) {
                        const int t = row & 2047;
#pragma unroll
                        for (int bj = 0; bj < 2; ++bj) { const float pos = (float)(bj ? (t & 63) : (t >> 6));
#pragma unroll
                            for (int n = 0; n < 2; ++n)
#pragma unroll
                                for (int e = 0; e < 4; ++e) { const float ang = pos * invf[n][e]; const float cs = __cosf(ang), sn = __sinf(ang);
                                    const float other = __shfl_xor(v[bj][n][e], 32);
                                    v[bj][n][e] = (fq >= 2) ? (v[bj][n][e] * cs + other * sn) : (v[bj][n][e] * cs - other * sn); } }
                    }
                }
#pragma unroll
                for (int bj = 0; bj < 2; ++bj) { u32x4 w; w.x = cvt_pk_bf16(v[bj][0][0], v[bj][0][1]); w.y = cvt_pk_bf16(v[bj][0][2], v[bj][0][3]); w.z = cvt_pk_bf16(v[bj][1][0], v[bj][1][1]); w.w = cvt_pk_bf16(v[bj][1][2], v[bj][1][3]);
                    *(u32x4*)(rowp + bj * 32) = w; }
                __builtin_amdgcn_sched_barrier(0); }
    }
};
template <class Epi, class Sched, bool ALIGN_EPI = false, bool SP2 = false>
__device__ __forceinline__ void gemm_phase(PG8_LAS unsigned char* lds, const Gemm g, const Sched& S, const Epi& E) {
    int tid_ = threadIdx.x; asm volatile("" : "+v"(tid_));
    const int tid = tid_, wid = __builtin_amdgcn_readfirstlane(tid >> 6), lane = tid & 63, wr = wid >> 2, wc = wid & 3, fr = lane & 15, fq = lane >> 4;
    const int K = g.K, nt = K / BK;
    unsigned voffA[2], voffB[2];
#pragma unroll
    for (int i = 0; i < 2; ++i) { int R, C; stage_rc(tid * 16 + i * 8192, R, C); const int Rb = Epi::PERM ? ((R & ~31) + perm32(R & 31)) : R;
        voffA[i] = (unsigned)(R * K + C) * 2u; voffB[i] = (unsigned)(Rb * K + C) * 2u; }
    const size_t kstep = (size_t)(BK * 2);
    const size_t hstep = (size_t)HALF * K * 2;
    const size_t tstep = 2 * hstep;
    const unsigned ldsw = (unsigned)wid * 1024u;
    const int aoff = lds_byte(wr * 64 + fr, fq * 8), boff = lds_byte(wc * 32 + fr, fq * 8);
#define PG8_SA(b, h) (((b) * 2 + (h)) * HTB)
#define PG8_SB(b, h) ((4 + (b) * 2 + (h)) * HTB)
#define PG8_STAGE(bufoff, gbase, voff) do { _Pragma("unroll") for (int _i = 0; _i < 2; ++_i) \
        __builtin_amdgcn_global_load_lds((const unsigned*)((const char*)(gbase) + (voff)[_i]), (PG8_LAS unsigned*)(lds + (bufoff) + ldsw + _i * 8192), 16, 0, 0); } while (0)
#define PG8_LDA(dst, b, h) do { _Pragma("unroll") for (int m = 0; m < 4; ++m) _Pragma("unroll") for (int k = 0; k < 2; ++k) dst[m][k] = *(const PG8_LAS bf16x8*)(lds + PG8_SA(b, h) + aoff + m * 2048 + k * 1024); } while (0)
#define PG8_LDB(dst, b, h) do { _Pragma("unroll") for (int n = 0; n < 2; ++n) _Pragma("unroll") for (int k = 0; k < 2; ++k) dst[n][k] = *(const PG8_LAS bf16x8*)(lds + PG8_SB(b, h) + boff + n * 2048 + k * 1024); } while (0)
#define PG8_MMA(ai, bj, At, Bt) do { __builtin_amdgcn_s_setprio(1); _Pragma("unroll") for (int m = 0; m < 4; ++m) _Pragma("unroll") for (int n = 0; n < 2; ++n) _Pragma("unroll") for (int k = 0; k < 2; ++k) \
        acc[ai][bj][m][n] = __builtin_amdgcn_mfma_f32_16x16x32_bf16(Bt[n][k], At[m][k], acc[ai][bj][m][n], 0, 0, 0); __builtin_amdgcn_s_setprio(0); } while (0)
#define PG8_WAIT_V(n) asm volatile("s_waitcnt vmcnt(" #n ")" ::: "memory")
#define PG8_WAIT_L(n) asm volatile("s_waitcnt lgkmcnt(" #n ")" ::: "memory")
#define PG8_BAR __builtin_amdgcn_s_barrier()
#define PG8_SCHED __builtin_amdgcn_sched_barrier(0)
    Unit cur, nxt; int ui = 0;
    if (!S.next(0, cur)) return;
    f32x4 acc[2][2][4][2];
#pragma unroll
    for (int a = 0; a < 2; ++a)
#pragma unroll
        for (int b = 0; b < 2; ++b)
#pragma unroll
            for (int m = 0; m < 4; ++m)
#pragma unroll
                for (int n = 0; n < 2; ++n) acc[a][b][m][n] = (f32x4){0.f, 0.f, 0.f, 0.f};
    bf16x8 At[4][2], B0[2][2], B1[2][2];
    const char* cA = (const char*)g.A + (size_t)cur.pm * tstep; const char* cB = (const char*)g.Bt + (size_t)cur.pn * tstep;
    S.a_ready(cur);
    if constexpr (SP2) {
        PG8_STAGE(PG8_SB(0, 0), cB, voffB); PG8_STAGE(PG8_SB(0, 1), cB + hstep, voffB); PG8_STAGE(PG8_SA(0, 0), cA, voffA); PG8_STAGE(PG8_SA(0, 1), cA + hstep, voffA);
        if (wr == 1) PG8_BAR;
        PG8_WAIT_V(2); PG8_BAR;
        PG8_STAGE(PG8_SB(1, 0), cB + kstep, voffB); PG8_STAGE(PG8_SA(1, 0), cA + kstep, voffA); PG8_STAGE(PG8_SB(1, 1), cB + hstep + kstep, voffB);
        PG8_WAIT_V(6); PG8_BAR;
    } else {
        PG8_STAGE(PG8_SB(0, 0), cB, voffB); PG8_STAGE(PG8_SA(0, 0), cA, voffA); PG8_STAGE(PG8_SB(0, 1), cB + hstep, voffB); PG8_STAGE(PG8_SA(0, 1), cA + hstep, voffA);
        if (wr == 1) PG8_BAR;
        PG8_WAIT_V(4); PG8_BAR;
        PG8_STAGE(PG8_SB(1, 0), cB + kstep, voffB); PG8_STAGE(PG8_SA(1, 0), cA + kstep, voffA); PG8_STAGE(PG8_SB(1, 1), cB + hstep + kstep, voffB);
        PG8_WAIT_V(6); PG8_BAR;
    }
    for (;;) {
        const bool has_next = S.next(ui + 1, nxt);
        const char* nA = has_next ? (const char*)g.A + (size_t)nxt.pm * tstep : cA; const char* nB = has_next ? (const char*)g.Bt + (size_t)nxt.pn * tstep : cB;
        for (int t = 0; t < nt; t += 2) {
            const bool last = (t == nt - 2);
            const char* a1 = cA + (size_t)(t + 1) * kstep;
            const char* a2 = last ? nA : cA + (size_t)(t + 2) * kstep; const char* b2 = last ? nB : cB + (size_t)(t + 2) * kstep;
            const char* a3 = a2 + kstep; const char* b3 = b2 + kstep;
            if (last && has_next) S.a_ready(nxt);
            if constexpr (SP2) {
            PG8_LDB(B0, 0, 0); PG8_LDB(B1, 0, 1); PG8_SCHED; PG8_LDA(At, 0, 0); PG8_STAGE(PG8_SA(1, 1), a1 + hstep, voffA);
            PG8_WAIT_V(8); PG8_WAIT_L(0); PG8_BAR; PG8_MMA(0, 0, At, B0); PG8_MMA(0, 1, At, B1); PG8_BAR; PG8_SCHED;
            PG8_LDA(At, 0, 1); PG8_STAGE(PG8_SB(0, 0), b2, voffB); PG8_STAGE(PG8_SB(0, 1), b2 + hstep, voffB); PG8_STAGE(PG8_SA(0, 0), a2, voffA);
            PG8_WAIT_V(8); PG8_WAIT_L(0); PG8_BAR; PG8_MMA(1, 0, At, B0); PG8_MMA(1, 1, At, B1); PG8_BAR; PG8_SCHED;
            PG8_LDB(B0, 1, 0); PG8_LDB(B1, 1, 1); PG8_SCHED; PG8_LDA(At, 1, 0); PG8_STAGE(PG8_SA(0, 1), a2 + hstep, voffA);
            PG8_WAIT_V(8); PG8_WAIT_L(0); PG8_BAR; PG8_MMA(0, 0, At, B0); PG8_MMA(0, 1, At, B1); PG8_BAR; PG8_SCHED;
            PG8_LDA(At, 1, 1); PG8_STAGE(PG8_SB(1, 0), b3, voffB); PG8_STAGE(PG8_SB(1, 1), b3 + hstep, voffB); PG8_STAGE(PG8_SA(1, 0), a3, voffA);
            PG8_WAIT_V(8); PG8_WAIT_L(0); PG8_BAR; PG8_MMA(1, 0, At, B0); PG8_MMA(1, 1, At, B1); PG8_BAR; PG8_SCHED;
            } else {
            PG8_LDB(B0, 0, 0); PG8_SCHED; PG8_LDA(At, 0, 0); PG8_STAGE(PG8_SA(1, 1), a1 + hstep, voffA);
            PG8_WAIT_L(8); PG8_BAR; PG8_WAIT_L(0); PG8_MMA(0, 0, At, B0); PG8_BAR; PG8_SCHED;
            PG8_LDB(B1, 0, 1); PG8_STAGE(PG8_SB(0, 0), b2, voffB);
            PG8_BAR; PG8_WAIT_L(0); PG8_MMA(0, 1, At, B1); PG8_BAR;
            PG8_LDA(At, 0, 1); PG8_STAGE(PG8_SA(0, 0), a2, voffA);
            PG8_BAR; PG8_WAIT_L(0); PG8_MMA(1, 0, At, B0); PG8_BAR; PG8_SCHED;
            PG8_STAGE(PG8_SB(0, 1), b2 + hstep, voffB);
            PG8_WAIT_V(6); PG8_BAR; PG8_MMA(1, 1, At, B1); PG8_BAR;
            PG8_LDB(B0, 1, 0); PG8_SCHED; PG8_LDA(At, 1, 0); PG8_STAGE(PG8_SA(0, 1), a2 + hstep, voffA);
            PG8_WAIT_L(8); PG8_BAR; PG8_WAIT_L(0); PG8_MMA(0, 0, At, B0); PG8_BAR; PG8_SCHED;
            PG8_LDB(B1, 1, 1); PG8_STAGE(PG8_SB(1, 0), b3, voffB);
            PG8_BAR; PG8_WAIT_L(0); PG8_MMA(0, 1, At, B1); PG8_BAR;
            PG8_LDA(At, 1, 1); PG8_STAGE(PG8_SA(1, 0), a3, voffA);
            PG8_BAR; PG8_WAIT_L(0); PG8_MMA(1, 0, At, B0); PG8_BAR; PG8_SCHED;
            PG8_STAGE(PG8_SB(1, 1), b3 + hstep, voffB);
            PG8_WAIT_V(6); PG8_BAR; PG8_MMA(1, 1, At, B1); PG8_BAR;
            }
        }
        if constexpr (ALIGN_EPI) { if (wr == 0) PG8_BAR; }
        if constexpr (!Epi::AFTER_DRAIN) { E(acc, cur, wr, wc, fr, fq); S.done(cur); }
        if (!has_next) break;
#pragma unroll
        for (int a = 0; a < 2; ++a)
#pragma unroll
            for (int b = 0; b < 2; ++b)
#pragma unroll
                for (int m = 0; m < 4; ++m)
#pragma unroll
                    for (int n = 0; n < 2; ++n) acc[a][b][m][n] = (f32x4){0.f, 0.f, 0.f, 0.f};
        cur = nxt; cA = nA; cB = nB; ++ui;
        if constexpr (ALIGN_EPI) { if (wr == 1) PG8_BAR; }
    }
    PG8_WAIT_V(0);
    if constexpr (!ALIGN_EPI) { if (wr == 0) PG8_BAR; }
    PG8_BAR;
    if constexpr (Epi::AFTER_DRAIN) { E.fused(acc, cur, wr, wc, fr, fq, lds, wid, lane); S.done(cur); }
#undef PG8_SA
#undef PG8_SB
#undef PG8_STAGE
#undef PG8_LDA
#undef PG8_LDB
#undef PG8_MMA
#undef PG8_WAIT_V
#undef PG8_WAIT_L
#undef PG8_BAR
#undef PG8_SCHED
}
}
#define N_LAUNCH_MODE 0

__device__ __forceinline__ float wave_sum(float v) {
#pragma unroll
    for (int o = 1; o < 64; o <<= 1) v += __shfl_xor(v, o);
    return v;
}
__device__ __forceinline__ float wave_max(float v) {
#pragma unroll
    for (int o = 1; o < 64; o <<= 1) v = fmaxf(v, __shfl_xor(v, o));
    return v;
}
__device__ __forceinline__ float uni(float v) { return __builtin_bit_cast(float, __builtin_amdgcn_readfirstlane(__builtin_bit_cast(int, v))); }
__device__ __forceinline__ unsigned cvtpk(float lo, float hi) { f32x2_t v = {lo, hi}; bf16x2_t b = __builtin_convertvector(v, bf16x2_t); return __builtin_bit_cast(unsigned, b); }
__device__ __forceinline__ float bf2f(unsigned short h) { return __uint_as_float((unsigned)h << 16); }
__device__ __forceinline__ int clampi(int v, int lo, int hi) { return v < lo ? lo : (v > hi ? hi : v); }

__device__ __forceinline__ void tr_item(const float* W, int K, int N, bf16* WT, int mode, LAS float* scr, int item, int lane, const float* gk = nullptr) {
    const int nblk = N / 32, kb = item / nblk, nb = item % nblk, k0 = 64 * kb, n0 = 32 * nb;
    const int drow0 = (mode == 0) ? n0 : (mode == 3) ? ((n0 & ~255) + 128 * ((n0 & 63) >> 5) + 32 * ((n0 & 255) >> 6)) : ((n0 >> 7) * 256 + (n0 & 127) + (mode == 2 ? 128 : 0));
#pragma unroll 8
    for (int i = 0; i < 32; ++i) { const int kk = 2 * i + (lane >> 5); const float gg = gk ? gk[k0 + kk] : 1.0f; scr[kk * 33 + (lane & 31)] = W[(size_t)(k0 + kk) * N + n0 + (lane & 31)] * gg; }
    asm volatile("s_waitcnt lgkmcnt(0)" ::: "memory");
    const int c = lane & 7;
#pragma unroll
    for (int j = 0; j < 4; ++j) { const int n = (lane >> 3) + 8 * j; const LAS float* s = scr + (8 * c) * 33 + n;
        u32x4 o; o.x = cvtpk(s[0 * 33], s[1 * 33]); o.y = cvtpk(s[2 * 33], s[3 * 33]); o.z = cvtpk(s[4 * 33], s[5 * 33]); o.w = cvtpk(s[6 * 33], s[7 * 33]);
        *(u32x4*)(WT + (size_t)(drow0 + n) * K + k0 + 8 * c) = o; }
    asm volatile("s_waitcnt lgkmcnt(0)" ::: "memory");
}

__device__ __forceinline__ void convert_weights(const Args& a, LAS unsigned char* lds, int gw, int ngw, int wave, int lane) {
    LAS float* scr = (LAS float*)(lds + wave * 16384);
    constexpr int I_F = (DM / 64) * (DFF / 32);
    constexpr int I_FFN = 4 * 3 * I_F;
    constexpr int I_ABIN = (DM / 64) * (LD0 / 32), I_SQ = (DM / 64) * (DM / 32), I_CIN = (DM / 64) * (LD1 / 32);
    constexpr int NITEMS = I_FFN + I_ABIN + I_SQ + I_CIN + I_SQ;
    for (int it = gw; it < NITEMS; it += ngw) {
        if (it < I_FFN) {
            const int i = it / (3 * I_F), r = it % (3 * I_F), which = r / I_F, item = r % I_F, l = i >> 1, f = i & 1;
            bf16* gu = (bf16*)(WSP + WS_FFN + (size_t)i * SZ_FFN); bf16* dn = (bf16*)(WSP + WS_FFN + (size_t)i * SZ_FFN + SZ_GU);
            const size_t woff = (size_t)l * DM * DFF;
            const float* gk = inp(a, f ? 23 : 2) + l * DM;
            if (which == 0)      tr_item(inp(a, f ? 24 : 3) + woff, DM, DFF, gu, 1, scr, item, lane, gk);
            else if (which == 1) tr_item(inp(a, f ? 25 : 4) + woff, DM, DFF, gu, 2, scr, item, lane, gk);
            else                 tr_item(inp(a, f ? 26 : 5) + woff, DFF, DM, dn, 0, scr, item, lane);
            continue;
        }
        int r = it - I_FFN;
        if (r < I_ABIN) { tr_item(inp(a, 7), DM, LD0, (bf16*)(WSP + WS_ABIN), 3, scr, r, lane, inp(a, 6)); continue; } r -= I_ABIN;
        if (r < I_SQ) { tr_item(inp(a, 8), DM, DM, (bf16*)(WSP + WS_ABOUT), 0, scr, r, lane); continue; } r -= I_SQ;
        if (r < I_CIN) { tr_item(inp(a, 19), DM, LD1, (bf16*)(WSP + WS_CIN), 3, scr, r, lane, inp(a, 6) + DM); continue; } r -= I_CIN;
        tr_item(inp(a, 20), DM, DM, (bf16*)(WSP + WS_COUT), 0, scr, r, lane);
    }
}

__device__ __forceinline__ void norm_phase(const float* xp, const float* xs, const float* g1, const float* g2, float* of32, bf16* obf, int mode, int gw, int ngw, int lane, float* S0 = nullptr) {
    f32x4 ga[4], gb[4];
#pragma unroll
    for (int j = 0; j < 4; ++j) { ga[j] = (mode == 1) ? (f32x4){1.f, 1.f, 1.f, 1.f} : *(const f32x4*)(g1 + 4 * lane + 256 * j); gb[j] = (mode == 2) ? *(const f32x4*)(g2 + 4 * lane + 256 * j) : (f32x4){0.f, 0.f, 0.f, 0.f}; }
    for (int m = gw; m < NTOK; m += ngw) {
        const float* xrow = (mode == 1 && m >= NPROMPT) ? xs + (size_t)(m - NPROMPT) * DM : xp + (size_t)m * DM;
        f32x4 v[4]; float ss = 0.f;
#pragma unroll
        for (int j = 0; j < 4; ++j) { v[j] = *(const f32x4*)(xrow + 4 * lane + 256 * j); ss += (v[j].x * v[j].x + v[j].y * v[j].y) + (v[j].z * v[j].z + v[j].w * v[j].w); }
        const float tot = wave_sum(ss);
        const float rstd = 1.0f / sqrtf(tot * (1.0f / DM) + EPS);
        f32x4 y[4];
#pragma unroll
        for (int j = 0; j < 4; ++j) y[j] = (mode == 1) ? v[j] : v[j] * rstd * ga[j];
        if (mode == 1 && lane == 0) S0[m] = tot;
        if (mode == 1) {
#pragma unroll
            for (int j = 0; j < 4; ++j) *(f32x4*)(of32 + (size_t)m * DM + 4 * lane + 256 * j) = v[j];
        }
        if (mode >= 2) {
#pragma unroll
            for (int j = 0; j < 4; ++j) *(f32x4*)(of32 + (size_t)m * DM + 4 * lane + 256 * j) = y[j];
        }
        if (mode == 2) {
            float s2 = 0.f;
#pragma unroll
            for (int j = 0; j < 4; ++j) s2 += (y[j].x * y[j].x + y[j].y * y[j].y) + (y[j].z * y[j].z + y[j].w * y[j].w);
            const float r2 = 1.0f / sqrtf(wave_sum(s2) * (1.0f / DM) + EPS);
#pragma unroll
            for (int j = 0; j < 4; ++j) y[j] = y[j] * r2 * gb[j];
        }
        if (mode != 3) {
#pragma unroll
            for (int j = 0; j < 4; ++j) { u32x2 w; w.x = cvtpk(y[j].x, y[j].y); w.y = cvtpk(y[j].z, y[j].w); *(u32x2*)(obf + (size_t)m * DM + 4 * lane + 256 * j) = w; }
        }
    }
}

__device__ __forceinline__ void qknorm_phase(const Args& a, int layer, bf16* qkv, int gtid, int gthreads, int lane) {
    const int cpr = layer == 0 ? 256 : 160, ld = layer == 0 ? LD0 : LD1;
    const long total = (long)NTOK * cpr;
    const int l8 = lane & 7;
    for (long idx = gtid; idx < total; idx += gthreads) {
        const int m = (int)(idx / cpr), ch = (int)(idx % cpr);
        int col; const float* g; bool isq;
        if (layer == 0) { col = ch < 128 ? ch * 8 : 1536 + (ch - 128) * 8;
            if (col < 512) { g = inp(a, 9); isq = true; } else if (col < 1024) { g = inp(a, 10); isq = false; } else if (col < 2048) { g = inp(a, 16); isq = true; } else { g = inp(a, 17); isq = false; } }
        else { col = ch * 8; if (col < 1024) { g = inp(a, 21); isq = true; } else { g = inp(a, 22); isq = false; } }
        bf16* p = qkv + (size_t)m * ld + col;
        const u32x4 raw = *(const u32x4*)p;
        float x[8];
#pragma unroll
        for (int j = 0; j < 4; ++j) { x[2 * j] = __uint_as_float(raw[j] << 16); x[2 * j + 1] = __uint_as_float(raw[j] & 0xffff0000u); }
        float ss = 0.f;
#pragma unroll
        for (int j = 0; j < 8; ++j) ss += x[j] * x[j];
        ss += __shfl_xor(ss, 1); ss += __shfl_xor(ss, 2); ss += __shfl_xor(ss, 4);
        const float rstd = 1.0f / sqrtf(ss * (1.0f / 64.0f) + EPS);
        const f32x4 g0 = *(const f32x4*)(g + l8 * 8), g1v = *(const f32x4*)(g + l8 * 8 + 4);
        x[0] *= rstd * g0.x; x[1] *= rstd * g0.y; x[2] *= rstd * g0.z; x[3] *= rstd * g0.w;
        x[4] *= rstd * g1v.x; x[5] *= rstd * g1v.y; x[6] *= rstd * g1v.z; x[7] *= rstd * g1v.w;
        if (layer == 1) {
            const int t = m & (SEQ - 1);
            const float pos = (float)((l8 >> 2) ? (t & 63) : (t >> 6));
            const bool second = (l8 >> 1) & 1;
#pragma unroll
            for (int j = 0; j < 8; ++j) {
                const int i = (l8 & 1) * 8 + j;
                const float invf = __builtin_amdgcn_exp2f(-(float)i * (13.287712379549449f / 16.0f));
                const float ang = pos * invf;
                const float cs = __cosf(ang), sn = __sinf(ang);
                const float other = __shfl_xor(x[j], 2);
                x[j] = second ? (x[j] * cs + other * sn) : (x[j] * cs - other * sn);
            }
        }
        const float sc = isq ? QSCALE : 1.0f;
        u32x4 w; w.x = cvtpk(x[0] * sc, x[1] * sc); w.y = cvtpk(x[2] * sc, x[3] * sc); w.z = cvtpk(x[4] * sc, x[5] * sc); w.w = cvtpk(x[6] * sc, x[7] * sc);
        *(u32x4*)p = w;
    }
}

__device__ __forceinline__ int crow(int r, int hi) { return (r & 3) + 8 * (r >> 2) + 4 * hi; }
__device__ __forceinline__ s16x4 vtr(const LAS unsigned char* p) { return __builtin_bit_cast(s16x4, __builtin_amdgcn_ds_read_tr16_b64_v4i16((LAS v4i16_t*)p)); }
#define MFMA32(a, b, c) __builtin_amdgcn_mfma_f32_32x32x16_bf16((a), (b), (c), 0, 0, 0)

struct ModNone {
    float negM;
    __device__ __forceinline__ void cinit(f32x16& c0, f32x16& c1, int) const {
#pragma unroll
        for (int r = 0; r < 16; ++r) { c0[r] = negM; c1[r] = negM; }
    }
};
struct ModAlibi {
    float negM, slope; int qpos, hi;
    __device__ __forceinline__ void cinit(f32x16& c0, f32x16& c1, int t) const {
        const float base = (float)(qpos - t * 64 - 4 * hi);
#pragma unroll
        for (int r = 0; r < 16; ++r) { const float off = (float)((r & 3) + 8 * (r >> 2));
            c0[r] = negM - slope * fabsf(base - off); c1[r] = negM - slope * fabsf(base - (off + 32.0f)); }
    }
};
struct ModNA {
    const float* rpb_h; float negM; int r, c, cs, rs, lo, hi;
    __device__ __forceinline__ void cinit(f32x16& c0, f32x16& c1, int t) const {
        const int rid = lo + t; const bool rowok = rid >= rs && rid < rs + 8;
        const float* brow = rpb_h + clampi(rid - r + 7, 0, 14) * 31;
#pragma unroll
        for (int q = 0; q < 16; ++q) { const int kc = 4 * hi + (q & 3) + 8 * (q >> 2);
            { const int idx = clampi(kc - c + 15, 0, 30); const float bias = brow[idx] * L2E + negM; c0[q] = (rowok && (unsigned)(kc - cs) < 16u) ? bias : -INFINITY; }
            { const int k2 = kc + 32; const int idx = clampi(k2 - c + 15, 0, 30); const float bias = brow[idx] * L2E + negM; c1[q] = (rowok && (unsigned)(k2 - cs) < 16u) ? bias : -INFINITY; } }
    }
};

template <int DV, bool PIPE, class Mod, int VAR = 0>
__device__ __forceinline__ void attn_loop(LAS unsigned char* lds, const bf16* Kg, const bf16* Vg, int ld, int nt,
                                          const bf16x8 (&qr)[4], f32x16 (&o)[DV / 32], float& l, const Mod& mod, int tid, int lane, int r32, int hi) {
    constexpr int KROW = 144, VROW = DV * 2 + 64, KSLOT = 64 * KROW, VSLOT = 64 * VROW, VBASE = 3 * KSLOT;
    const int lkv = tid >> 3, lch = tid & 7;
    const bf16* kp = Kg + (size_t)lkv * ld + lch * 8;
    const bf16* vp = Vg + (size_t)lkv * ld + lch * 8;
    u32x4 kreg = *(const u32x4*)kp, vreg0 = *(const u32x4*)vp, vreg1 = (u32x4){0u, 0u, 0u, 0u};
    if (DV == 128) vreg1 = *(const u32x4*)(vp + 64);
    LAS unsigned char* kdst = lds + lkv * KROW + lch * 16;
    LAS unsigned char* vdst = lds + VBASE + lkv * VROW + lch * 16;
    const LAS unsigned char* kfr = lds + r32 * KROW + hi * 16;
    const LAS unsigned char* vfr = lds + VBASE + (4 * hi + ((lane & 15) >> 2)) * VROW + (16 * ((lane >> 4) & 1) + 4 * (lane & 3)) * 2;
#define ATT_LOADT(tt) do { const size_t adv_ = (size_t)(tt) * 64 * ld; kreg = *(const u32x4*)(kp + adv_); vreg0 = *(const u32x4*)(vp + adv_); if (DV == 128) vreg1 = *(const u32x4*)(vp + adv_ + 64); } while (0)
#define ATT_STORE(slot) do { *(LAS u32x4*)(kdst + (slot) * KSLOT) = kreg; *(LAS u32x4*)(vdst + (slot) * VSLOT) = vreg0; if (DV == 128) *(LAS u32x4*)(vdst + (slot) * VSLOT + 128) = vreg1; } while (0)
#define ATT_QK(S0, S1, slot) do { _Pragma("unroll") for (int d0 = 0; d0 < 4; ++d0) { \
        const bf16x8 k0_ = *(const LAS bf16x8*)(kfr + (slot) * KSLOT + d0 * 32), k1_ = *(const LAS bf16x8*)(kfr + (slot) * KSLOT + 32 * KROW + d0 * 32); \
        S0 = MFMA32(k0_, qr[d0], S0); S1 = MFMA32(k1_, qr[d0], S1); } } while (0)
    __syncthreads();
    ATT_STORE(0);
    f32x16 s0, s1;
    if (PIPE) {
        __syncthreads();
        ATT_LOADT(nt > 1 ? 1 : 0);
        mod.cinit(s0, s1, 0);
        ATT_QK(s0, s1, 0);
    } else {
        ATT_LOADT(nt > 1 ? 1 : 0);
    }
    int sc = 0, sn = 1, snn = 2;
    for (int t = 0; t < nt; ++t) {
        if (!(VAR & 8)) ATT_STORE(sn);
        __syncthreads();
        if (!(VAR & 8)) { const int tn = t + 2 < nt ? t + 2 : nt - 1; ATT_LOADT(tn); }
        __builtin_amdgcn_sched_barrier(0);
        f32x16 n0, n1;
        if (PIPE && DV == 64 && VAR == 0) {
            bf16x8 kf[8]; s16x4 vl[8], vh[8];
#pragma unroll
            for (int d0 = 0; d0 < 4; ++d0) { kf[2 * d0] = *(const LAS bf16x8*)(kfr + sn * KSLOT + d0 * 32); kf[2 * d0 + 1] = *(const LAS bf16x8*)(kfr + sn * KSLOT + 32 * KROW + d0 * 32); }
#pragma unroll
            for (int db = 0; db < 2; ++db)
#pragma unroll
                for (int c = 0; c < 4; ++c) { vl[db * 4 + c] = vtr(vfr + sc * VSLOT + (16 * c) * VROW + db * 64); vh[db * 4 + c] = vtr(vfr + sc * VSLOT + (16 * c + 8) * VROW + db * 64); }
            __builtin_amdgcn_sched_barrier(0);
            mod.cinit(n0, n1, t + 1);
#pragma unroll
            for (int d0 = 0; d0 < 4; ++d0) { n0 = MFMA32(kf[2 * d0], qr[d0], n0); n1 = MFMA32(kf[2 * d0 + 1], qr[d0], n1); }
            float rs = 0.f;
#pragma unroll
            for (int r = 0; r < 16; ++r) { s0[r] = __builtin_amdgcn_exp2f(s0[r]); s1[r] = __builtin_amdgcn_exp2f(s1[r]); rs += s0[r] + s1[r]; }
            l += rs;
            bf16x8 pa[4];
            { u32x4 w;
              w.x = cvtpk(s0[0], s0[1]); w.y = cvtpk(s0[2], s0[3]); w.z = cvtpk(s0[4], s0[5]); w.w = cvtpk(s0[6], s0[7]); pa[0] = __builtin_bit_cast(bf16x8, w);
              w.x = cvtpk(s0[8], s0[9]); w.y = cvtpk(s0[10], s0[11]); w.z = cvtpk(s0[12], s0[13]); w.w = cvtpk(s0[14], s0[15]); pa[1] = __builtin_bit_cast(bf16x8, w);
              w.x = cvtpk(s1[0], s1[1]); w.y = cvtpk(s1[2], s1[3]); w.z = cvtpk(s1[4], s1[5]); w.w = cvtpk(s1[6], s1[7]); pa[2] = __builtin_bit_cast(bf16x8, w);
              w.x = cvtpk(s1[8], s1[9]); w.y = cvtpk(s1[10], s1[11]); w.z = cvtpk(s1[12], s1[13]); w.w = cvtpk(s1[14], s1[15]); pa[3] = __builtin_bit_cast(bf16x8, w); }
#pragma unroll
            for (int c = 0; c < 4; ++c)
#pragma unroll
                for (int db = 0; db < 2; ++db) {
                    const bf16x8 vf = (bf16x8){vl[db * 4 + c][0], vl[db * 4 + c][1], vl[db * 4 + c][2], vl[db * 4 + c][3], vh[db * 4 + c][0], vh[db * 4 + c][1], vh[db * 4 + c][2], vh[db * 4 + c][3]};
                    o[db] = MFMA32(vf, pa[c], o[db]);
                }
        } else {
        if (PIPE) {
            mod.cinit(n0, n1, t + 1);
            if (!(VAR & 4)) ATT_QK(n0, n1, sn);
        } else {
            mod.cinit(s0, s1, t);
            if (!(VAR & 4)) ATT_QK(s0, s1, sc);
        }
        float rs = 0.f;
#pragma unroll
        for (int r = 0; r < 16; ++r) { if (!(VAR & 1)) { s0[r] = __builtin_amdgcn_exp2f(s0[r]); s1[r] = __builtin_amdgcn_exp2f(s1[r]); } rs += s0[r] + s1[r]; }
        l += rs;
        bf16x8 pa[4];
        { u32x4 w;
          w.x = cvtpk(s0[0], s0[1]); w.y = cvtpk(s0[2], s0[3]); w.z = cvtpk(s0[4], s0[5]); w.w = cvtpk(s0[6], s0[7]); pa[0] = __builtin_bit_cast(bf16x8, w);
          w.x = cvtpk(s0[8], s0[9]); w.y = cvtpk(s0[10], s0[11]); w.z = cvtpk(s0[12], s0[13]); w.w = cvtpk(s0[14], s0[15]); pa[1] = __builtin_bit_cast(bf16x8, w);
          w.x = cvtpk(s1[0], s1[1]); w.y = cvtpk(s1[2], s1[3]); w.z = cvtpk(s1[4], s1[5]); w.w = cvtpk(s1[6], s1[7]); pa[2] = __builtin_bit_cast(bf16x8, w);
          w.x = cvtpk(s1[8], s1[9]); w.y = cvtpk(s1[10], s1[11]); w.z = cvtpk(s1[12], s1[13]); w.w = cvtpk(s1[14], s1[15]); pa[3] = __builtin_bit_cast(bf16x8, w); }
        if (!(VAR & 2)) {
#pragma unroll
        for (int db = 0; db < DV / 32; ++db)
#pragma unroll
            for (int c = 0; c < 4; ++c) {
                s16x4 lo4, hi4;
                if (VAR & 16) { lo4 = *(const LAS s16x4*)(vfr + sc * VSLOT + (16 * c) * VROW + db * 64); hi4 = *(const LAS s16x4*)(vfr + sc * VSLOT + (16 * c + 8) * VROW + db * 64); }
                else { lo4 = vtr(vfr + sc * VSLOT + (16 * c) * VROW + db * 64); hi4 = vtr(vfr + sc * VSLOT + (16 * c + 8) * VROW + db * 64); }
                const bf16x8 vf = (bf16x8){lo4[0], lo4[1], lo4[2], lo4[3], hi4[0], hi4[1], hi4[2], hi4[3]};
                o[db] = MFMA32(vf, pa[c], o[db]);
            }
        } else { o[0][0] += __builtin_bit_cast(float, (int)pa[0][0] + (int)pa[1][1] + (int)pa[2][2] + (int)pa[3][3]); }
        }
        if (PIPE) { s0 = n0; s1 = n1; }
        { const int tmp = sc; sc = sn; sn = snn; snn = tmp; }
    }
#undef ATT_LOADT
#undef ATT_STORE
#undef ATT_QK
}

__device__ __forceinline__ void load_q(bf16x8 (&qr)[4], const bf16* qrow, int hi) {
#pragma unroll
    for (int d0 = 0; d0 < 4; ++d0) qr[d0] = *(const bf16x8*)(qrow + d0 * 16 + hi * 8);
}
__device__ __forceinline__ void store_o32(bf16* dst  , const f32x16& v, int hi) {
#pragma unroll
    for (int g = 0; g < 4; ++g) { u32x2 w; w.x = cvtpk(v[4 * g], v[4 * g + 1]); w.y = cvtpk(v[4 * g + 2], v[4 * g + 3]); *(u32x2*)(dst + 8 * g + 4 * hi) = w; }
}

__device__ __forceinline__ void attn_loop64(LAS unsigned char* lds, const bf16* Kg, const bf16* Vg, int ld, int nt, float negM,
                                            const bf16x8 (&qa)[4], const bf16x8 (&qb)[4], f32x16 (&oa)[2], f32x16 (&ob)[2], float& la, float& lb, int tid, int lane, int r32, int hi) {
    constexpr int KROW = 144, VROW = 192, KSLOT = 64 * KROW, VSLOT = 64 * VROW, VBASE = 3 * KSLOT;
    const int lkv = tid >> 3, lch = tid & 7;
    const bf16* kp = Kg + (size_t)lkv * ld + lch * 8;
    const bf16* vp = Vg + (size_t)lkv * ld + lch * 8;
    LAS unsigned char* kdst = lds + lkv * KROW + lch * 16;
    LAS unsigned char* vdst = lds + VBASE + lkv * VROW + lch * 16;
    const LAS unsigned char* kfr = lds + r32 * KROW + hi * 16;
    const LAS unsigned char* vfr = lds + VBASE + (4 * hi + ((lane & 15) >> 2)) * VROW + (16 * ((lane >> 4) & 1) + 4 * (lane & 3)) * 2;
    u32x4 kreg = *(const u32x4*)kp, vreg = *(const u32x4*)vp;
    __syncthreads();
    *(LAS u32x4*)kdst = kreg; *(LAS u32x4*)vdst = vreg;
    { const size_t adv = (size_t)(nt > 1 ? 1 : 0) * 64 * ld; kreg = *(const u32x4*)(kp + adv); vreg = *(const u32x4*)(vp + adv); }
    int sc = 0, sn = 1, snn = 2;
    for (int t = 0; t < nt; ++t) {
        *(LAS u32x4*)(kdst + sn * KSLOT) = kreg; *(LAS u32x4*)(vdst + sn * VSLOT) = vreg;
        __syncthreads();
        { const int tn = t + 2 < nt ? t + 2 : nt - 1; const size_t adv = (size_t)tn * 64 * ld; kreg = *(const u32x4*)(kp + adv); vreg = *(const u32x4*)(vp + adv); }
        __builtin_amdgcn_sched_barrier(0);
        f32x16 a0, a1, b0, b1;
#pragma unroll
        for (int r = 0; r < 16; ++r) { a0[r] = negM; a1[r] = negM; b0[r] = negM; b1[r] = negM; }
#pragma unroll
        for (int d0 = 0; d0 < 4; ++d0) {
            const bf16x8 k0 = *(const LAS bf16x8*)(kfr + sc * KSLOT + d0 * 32), k1 = *(const LAS bf16x8*)(kfr + sc * KSLOT + 32 * KROW + d0 * 32);
            a0 = MFMA32(k0, qa[d0], a0); b0 = MFMA32(k0, qb[d0], b0); a1 = MFMA32(k1, qa[d0], a1); b1 = MFMA32(k1, qb[d0], b1);
        }
        float ra = 0.f, rb = 0.f;
#pragma unroll
        for (int r = 0; r < 16; ++r) { a0[r] = __builtin_amdgcn_exp2f(a0[r]); a1[r] = __builtin_amdgcn_exp2f(a1[r]); ra += a0[r] + a1[r];
                                       b0[r] = __builtin_amdgcn_exp2f(b0[r]); b1[r] = __builtin_amdgcn_exp2f(b1[r]); rb += b0[r] + b1[r]; }
        la += ra; lb += rb;
        bf16x8 pa[4], pb[4];
#define A64_PACK(P, S0, S1) do { u32x4 w_; \
        w_.x = cvtpk(S0[0], S0[1]); w_.y = cvtpk(S0[2], S0[3]); w_.z = cvtpk(S0[4], S0[5]); w_.w = cvtpk(S0[6], S0[7]); P[0] = __builtin_bit_cast(bf16x8, w_); \
        w_.x = cvtpk(S0[8], S0[9]); w_.y = cvtpk(S0[10], S0[11]); w_.z = cvtpk(S0[12], S0[13]); w_.w = cvtpk(S0[14], S0[15]); P[1] = __builtin_bit_cast(bf16x8, w_); \
        w_.x = cvtpk(S1[0], S1[1]); w_.y = cvtpk(S1[2], S1[3]); w_.z = cvtpk(S1[4], S1[5]); w_.w = cvtpk(S1[6], S1[7]); P[2] = __builtin_bit_cast(bf16x8, w_); \
        w_.x = cvtpk(S1[8], S1[9]); w_.y = cvtpk(S1[10], S1[11]); w_.z = cvtpk(S1[12], S1[13]); w_.w = cvtpk(S1[14], S1[15]); P[3] = __builtin_bit_cast(bf16x8, w_); } while (0)
        A64_PACK(pa, a0, a1); A64_PACK(pb, b0, b1);
#undef A64_PACK
#pragma unroll
        for (int c = 0; c < 4; ++c)
#pragma unroll
            for (int db = 0; db < 2; ++db) {
                const s16x4 lo4 = vtr(vfr + sc * VSLOT + (16 * c) * VROW + db * 64), hi4 = vtr(vfr + sc * VSLOT + (16 * c + 8) * VROW + db * 64);
                const bf16x8 vf = (bf16x8){lo4[0], lo4[1], lo4[2], lo4[3], hi4[0], hi4[1], hi4[2], hi4[3]};
                oa[db] = MFMA32(vf, pa[c], oa[db]); ob[db] = MFMA32(vf, pb[c], ob[db]);
            }
        { const int tmp = sc; sc = sn; sn = snn; snn = tmp; }
    }
}
__device__ __forceinline__ void gqa_unit64(LAS unsigned char* lds, const bf16* qkv, bf16* O, float negM, int b, int head, int qb4, int tid, int wid, int lane) {
    asm volatile("" : "+v"(tid));
    lane = tid & 63; const int r32 = lane & 31, hi = lane >> 5;
    const size_t tok0 = (size_t)b * SEQ, qtok = tok0 + qb4 * 512 + wid * 64 + r32;
    bf16x8 qa[4], qb[4]; load_q(qa, qkv + qtok * LD1 + head * 64, hi); load_q(qb, qkv + (qtok + 32) * LD1 + head * 64, hi);
    const bf16* Kg = qkv + tok0 * LD1 + 1024 + (head >> 2) * 64;
    f32x16 oa[2], ob[2]; oa[0] = (f32x16){}; oa[1] = (f32x16){}; ob[0] = (f32x16){}; ob[1] = (f32x16){};
    float la = 0.f, lb = 0.f;
    attn_loop64(lds, Kg, Kg + 256, LD1, SEQ / 64, negM, qa, qb, oa, ob, la, lb, tid, lane, r32, hi);
    const float ia = 1.0f / (la + __shfl_xor(la, 32)), ib = 1.0f / (lb + __shfl_xor(lb, 32));
    bf16* orow = O + qtok * DM + head * 64;
    store_o32(orow, oa[0] * ia, hi); store_o32(orow + 32, oa[1] * ia, hi);
    store_o32(orow + 32 * DM, ob[0] * ib, hi); store_o32(orow + 32 * DM + 32, ob[1] * ib, hi);
}

template <int VAR>
__device__ __forceinline__ void gqa_unit(LAS unsigned char* lds, const bf16* qkv, bf16* O, float negM, int b, int head, int qb, int tid, int wid, int lane) {
    asm volatile("" : "+v"(tid));
    lane = tid & 63; const int r32 = lane & 31, hi = lane >> 5;
    const size_t tok0 = (size_t)b * SEQ, qtok = tok0 + qb * 256 + wid * 32 + r32;
    bf16x8 qr[4]; load_q(qr, qkv + qtok * LD1 + head * 64, hi);
    const bf16* Kg = qkv + tok0 * LD1 + 1024 + (head >> 2) * 64;
    f32x16 o[2]; o[0] = (f32x16){}; o[1] = (f32x16){};
    float l = 0.f;
    ModNone mod; mod.negM = negM;
    attn_loop<64, true, ModNone, VAR>(lds, Kg, Kg + 256, LD1, SEQ / 64, qr, o, l, mod, tid, lane, r32, hi);
    const float inv = 1.0f / (l + __shfl_xor(l, 32));
    bf16* orow = O + qtok * DM + head * 64;
    store_o32(orow, o[0] * inv, hi); store_o32(orow + 32, o[1] * inv, hi);
}

__device__ __forceinline__ void na_unit(LAS unsigned char* lds, const bf16* qkv, bf16* O, const float* rpb, float negM, int b, int h, int g, int tid, int wid, int lane) {
    asm volatile("" : "+v"(tid));
    lane = tid & 63; const int r32 = lane & 31, hi = lane >> 5;
    const int r = 4 * g + (wid >> 1), c = 32 * (wid & 1) + r32;
    const size_t tok0 = (size_t)b * SEQ, qtok = tok0 + r * 64 + c;
    const int lo = clampi(4 * g - 4, 0, 24), hirow = clampi(4 * g - 1, 0, 24) + 7;
    bf16x8 qr[4]; load_q(qr, qkv + qtok * LD0 + 1536 + h * 64, hi);
    const bf16* Kg = qkv + (tok0 + (size_t)lo * 64) * LD0 + 2048 + h * 64;
    f32x16 o[2]; o[0] = (f32x16){}; o[1] = (f32x16){};
    float l = 0.f;
    ModNA mod; mod.negM = negM; mod.rpb_h = rpb + h * 15 * 31; mod.r = r; mod.c = c; mod.cs = clampi(c - 8, 0, 48); mod.rs = clampi(r - 4, 0, 24); mod.lo = lo; mod.hi = hi;
    attn_loop<64, true, ModNA>(lds, Kg, Kg + 512, LD0, hirow - lo + 1, qr, o, l, mod, tid, lane, r32, hi);
    const float inv = 1.0f / (l + __shfl_xor(l, 32));
    bf16* orow = O + qtok * DM + 512 + h * 64;
    store_o32(orow, o[0] * inv, hi); store_o32(orow + 32, o[1] * inv, hi);
}

__device__ __forceinline__ void diff_unit(LAS unsigned char* lds, const bf16* qkv, bf16* O, float* stash  , const float* subg, float lam, float post, float negM, int b, int h, int qb, int tid, int wid, int lane) {
    asm volatile("" : "+v"(tid));
    lane = tid & 63; const int r32 = lane & 31, hi = lane >> 5;
    const int qpos = qb * 256 + wid * 32 + r32;
    const size_t tok0 = (size_t)b * SEQ, qtok = tok0 + qpos;
    ModAlibi mod; mod.negM = negM; mod.slope = __builtin_amdgcn_exp2f(-2.0f * (float)(h + 1)) * L2E; mod.qpos = qpos; mod.hi = hi;
    const bf16* Vg = qkv + tok0 * LD0 + 1024 + h * 128;
#pragma unroll 1
    for (int c = 0; c < 2; ++c) {
        bf16x8 qr[4]; load_q(qr, qkv + qtok * LD0 + h * 128 + c * 64, hi);
        const bf16* Kg = qkv + tok0 * LD0 + 512 + h * 128 + c * 64;
        f32x16 o[4];
#pragma unroll
        for (int db = 0; db < 4; ++db) o[db] = (f32x16){};
        float l = 0.f;
        attn_loop<128, false, ModAlibi>(lds, Kg, Vg, LD0, SEQ / 64, qr, o, l, mod, tid, lane, r32, hi);
        const float coef = (c == 0 ? 1.0f : -lam) / (l + __shfl_xor(l, 32));
        f32x4* st = (f32x4*)(stash + (size_t)tid * 64);
        if (c == 0) {
#pragma unroll
            for (int db = 0; db < 4; ++db)
#pragma unroll
                for (int g = 0; g < 4; ++g) st[db * 4 + g] = (f32x4){o[db][4 * g], o[db][4 * g + 1], o[db][4 * g + 2], o[db][4 * g + 3]} * coef;
        } else {
            float ss = 0.f;
#pragma unroll
            for (int db = 0; db < 4; ++db)
#pragma unroll
                for (int g = 0; g < 4; ++g) { const f32x4 p = st[db * 4 + g];
#pragma unroll
                    for (int e = 0; e < 4; ++e) { o[db][4 * g + e] = p[e] + o[db][4 * g + e] * coef; ss += o[db][4 * g + e] * o[db][4 * g + e]; } }
            ss += __shfl_xor(ss, 32);
            const float rstd = post / sqrtf(ss * (1.0f / 128.0f) + EPS);
            bf16* orow = O + qtok * DM + h * 128;
#pragma unroll
            for (int db = 0; db < 4; ++db) {
                f32x16 v = o[db];
#pragma unroll
                for (int g = 0; g < 4; ++g) { const f32x4 gg = *(const f32x4*)(subg + 32 * db + 8 * g + 4 * hi);
                    v[4 * g] *= rstd * gg.x; v[4 * g + 1] *= rstd * gg.y; v[4 * g + 2] *= rstd * gg.z; v[4 * g + 3] *= rstd * gg.w; }
                store_o32(orow + 32 * db, v, hi);
            }
        }
    }
}

#define RLX_AGENT __ATOMIC_RELAXED, __HIP_MEMORY_SCOPE_AGENT
#define LDS_WAIT() asm volatile("s_waitcnt lgkmcnt(0)" ::: "memory")
#define VM_WAIT() asm volatile("s_waitcnt vmcnt(0)" ::: "memory")
__device__ __forceinline__ unsigned long long rt() { return __builtin_amdgcn_s_memrealtime(); }
#define XB_TMO      128
#define XB_XCNT(j)  (256  + 64 * (j))
#define XB_XSUB(j)  (1280 + 64 * (j))
#define XB_XGEN(j)  (2304 + 64 * (j))
#define XB_TOP      3328
#define XB_TOPGEN   3392
#define XCD_BAR_WORDS 3456
#define XB_SPIN_CAP (1u << 18)

__device__ __forceinline__ unsigned xb_ld(unsigned* p)              { return __hip_atomic_load(p, __ATOMIC_RELAXED, __HIP_MEMORY_SCOPE_AGENT); }
__device__ __forceinline__ unsigned xb_add(unsigned* p, unsigned v) { return __hip_atomic_fetch_add(p, v, __ATOMIC_RELAXED, __HIP_MEMORY_SCOPE_AGENT); }
__device__ __forceinline__ unsigned xb_xcc_id() { return (unsigned)__builtin_amdgcn_s_getreg((3 << 11) | 20) & 0xFu; }
#define XB_SPIN(cond, bar) do { unsigned _sp = 0; while (cond) { __builtin_amdgcn_s_sleep(1); \
    if ((++_sp & 255u) == 0u) { if (xb_ld(&(bar)[XB_TMO])) break; if (_sp > XB_SPIN_CAP) { atomicAdd(&(bar)[XB_TMO], 1u); break; } } } } while (0)

struct XcdBarrier {
    unsigned* bar; unsigned x;
    volatile LAS unsigned* st;
};

__device__ __forceinline__ XcdBarrier xcd_barrier_post(unsigned* bar, volatile LAS unsigned* st) {
    XcdBarrier b; b.bar = bar; b.x = xb_xcc_id(); b.st = st;
    if (threadIdx.x == 0) (void)xb_add(&bar[XB_XCNT(b.x)], 1u);
    return b;
}
__device__ __forceinline__ void xcd_barrier_complete(unsigned* bar, unsigned x, unsigned& nloc, unsigned& nx) {
    const unsigned G = gridDim.x * gridDim.y * gridDim.z;
    unsigned sum, cnt, mine, sp = 0u;
    for (;;) {
        sum = 0u; cnt = 0u; mine = 0u;
#pragma unroll
        for (unsigned j = 0; j < 16; ++j) { const unsigned c = xb_ld(&bar[XB_XCNT(j)]); sum += c; cnt += (c > 0u) ? 1u : 0u; mine = (j == x) ? c : mine; }
        if (sum == G) break;
        __builtin_amdgcn_s_sleep(1);
        if ((++sp & 255u) == 0u) { if (xb_ld(&bar[XB_TMO])) break; if (sp > XB_SPIN_CAP) { atomicAdd(&bar[XB_TMO], 1u); break; } }
    }
    nloc = mine > 0u ? mine : 1u; nx = cnt > 0u ? cnt : 1u;
}

__device__ __forceinline__ void xcd_barrier(const XcdBarrier& b) {
    asm volatile("s_waitcnt vmcnt(0)" ::: "memory");
    __syncthreads();
    if (threadIdx.x == 0) {
        unsigned* bar = b.bar;
        __builtin_amdgcn_s_waitcnt(0);
        unsigned nloc = b.st[0], nx = b.st[1];
        if (nloc == 0u) { xcd_barrier_complete(bar, b.x, nloc, nx); b.st[0] = nloc; b.st[1] = nx; }
        const unsigned old = xb_add(&bar[XB_XSUB(b.x)], 1u);
        const unsigned gen = old / nloc;
        if (old + 1u == (gen + 1u) * nloc) {
            __builtin_amdgcn_fence(__ATOMIC_RELEASE, "agent");
            asm volatile("s_waitcnt vmcnt(0)" ::: "memory");
            const unsigned og = xb_add(&bar[XB_TOP], 1u);
            const unsigned tg = og / nx;
            if (og + 1u == (tg + 1u) * nx) xb_add(&bar[XB_TOPGEN], 1u);
            else XB_SPIN(xb_ld(&bar[XB_TOPGEN]) == tg, bar);
            __builtin_amdgcn_fence(__ATOMIC_ACQUIRE, "agent");
            xb_add(&bar[XB_XGEN(b.x)], 1u);
            asm volatile("s_waitcnt vmcnt(0)" ::: "memory");
        } else {
            XB_SPIN(xb_ld(&bar[XB_XGEN(b.x)]) == gen, bar);
            __builtin_amdgcn_fence(__ATOMIC_ACQUIRE, "agent");
            asm volatile("s_waitcnt vmcnt(0)" ::: "memory");
        }
    }
    __syncthreads();
}

__global__ void __launch_bounds__(NTHREADS, 2) trunk_fwd(Args a) {
    extern __shared__ __attribute__((aligned(16))) unsigned char lds_raw[];
    LAS unsigned char* lds = (LAS unsigned char*)lds_raw;
#define G (kargs()->grid)
#define bid (opaque_bid())
#define gw (bid * NWAVES + wave)
#define ngw (G * NWAVES)
#define X (kargs()->out)
#define XN ((bf16*)(WSP + WS_XN))
#define BIG ((bf16*)(WSP + WS_BIG))
#define SS(k) ((float*)(WSP + WS_S) + (size_t)(k) * NTOK)

    volatile LAS unsigned* bst = (volatile LAS unsigned*)(lds + 131072);
    if (threadIdx.x < 2) bst[threadIdx.x] = 0u;
    __syncthreads();
    XcdBarrier xbar = xcd_barrier_post((unsigned*)(WSP + WS_CTL) + kargs()->li * XCD_BAR_WORDS, bst);
    for (int ph = kargs()->lo; ph < kargs()->hi; ++ph) {
        int tid_ = threadIdx.x; asm volatile("" : "+v"(tid_));
        const int tid = tid_, lane = tid & 63, wave = __builtin_amdgcn_readfirstlane(tid >> 6);
        if (ph == 0) {
            convert_weights(a, lds, gw, ngw, wave, lane);
            { float* Sz = SS(1); for (int i = bid * NTHREADS + tid; i < 7 * NTOK; i += G * NTHREADS) Sz[i] = 0.f; }
            norm_phase(inp(a, 0), inp(a, 1), nullptr, nullptr, X, XN, 1, gw, ngw, lane, SS(0));
        } else if (ph == 15) {
            norm_phase(X, nullptr, inp(a, 27) + DM, nullptr, X, nullptr, 3, gw, ngw, lane);
        } else {
            const int L = (ph - 1) / 7, s = (ph - 1) % 7;
            if (s == 0 || s == 5) {
                const int i = 2 * L + (s == 5);
                const bf16* A = (s == 5) ? (const bf16*)(WSP + WS_XB2) : XN;
                const int sai = (s == 5) ? 2 + 4 * L : (L == 0 ? 0 : 3), sbi = (s == 0 && L == 1) ? 4 : -1;
                pg8::Gemm g{A, (const bf16*)(WSP + WS_FFN + (size_t)i * SZ_FFN), NTOK, 2 * DFF, DM};
                pg8::StaticOrder S; S.init(NTOK, 2 * DFF, G, bid);
                pg8::EpiSwiglu2 E{sai, sbi};
                pg8::gemm_phase<pg8::EpiSwiglu2, pg8::StaticOrder, true, true>(lds, g, S, E);
            } else if (s == 1 || s == 6) {
                const int i = 2 * L + (s == 6);
                pg8::Gemm g{BIG, (const bf16*)(WSP + WS_FFN + (size_t)i * SZ_FFN + SZ_GU), NTOK, DM, DFF};
                pg8::StaticOrder S; S.init(NTOK, DM, G, bid);
                pg8::EpiRes2 E; E.alpha = 0.5f * (float)kargs()->ascale; E.s2i = -1; E.sini = -1; E.gsel = 0;
                if (s == 1) { E.xbsel = 1; E.s1i = 1 + 4 * L; if (L == 1) { E.sini = 3; E.gsel = 1; } }
                else if (L == 0) { E.xbsel = 1; E.s1i = 3; E.s2i = 4; E.gsel = 2; }
                else { E.xbsel = 0; E.s1i = 7; }
                pg8::gemm_phase<pg8::EpiRes2, pg8::StaticOrder, true, true>(lds, g, S, E);
            } else if (s == 4) {
                pg8::Gemm g{XN, (const bf16*)(WSP + (L == 0 ? WS_ABOUT : WS_COUT)), NTOK, DM, DM};
                pg8::StaticOrder S; S.init(NTOK, DM, G, bid);
                pg8::EpiRes2 E; E.alpha = 1.0f * (float)kargs()->ascale; E.s1i = 2 + 4 * L; E.s2i = -1; E.sini = -1; E.xbsel = 2; E.gsel = 0;
                pg8::gemm_phase<pg8::EpiRes2, pg8::StaticOrder, true, true>(lds, g, S, E);
            } else if (s == 2 && L == 0) {
                pg8::Gemm g{XN, (const bf16*)(WSP + WS_ABIN), NTOK, LD0, DM};
                pg8::StaticOrder S; S.init(NTOK, LD0, G, bid);
                pg8::EpiQKV E{LD0, 1, 0};
                pg8::gemm_phase<pg8::EpiQKV, pg8::StaticOrder, true, true>(lds, g, S, E);
            } else if (s == 2) {
                pg8::Gemm g{XN, (const bf16*)(WSP + WS_CIN), NTOK, LD1, DM};
                pg8::StaticOrder S; S.init(NTOK, LD1, G, bid);
                pg8::EpiQKV E{LD1, 5, 1};
                pg8::gemm_phase<pg8::EpiQKV, pg8::StaticOrder, true, true>(lds, g, S, E);
            } else {
                if (L == 0) {
                    const float d1 = wave_sum(inp(a, 11)[lane] * inp(a, 12)[lane]), d2 = wave_sum(inp(a, 13)[lane] * inp(a, 14)[lane]);
                    const float lambda_init = 0.2f;
                    const float lam = uni(__expf(d1) - __expf(d2) + lambda_init);
                    const float negMa = uni(-(64.0f * QSCALE * 1.01f) * wave_max(fabsf(inp(a, 9)[lane])) * wave_max(fabsf(inp(a, 10)[lane])));
                    float rmax = 0.f;
                    for (int i = lane; i < 8 * 15 * 31; i += 64) rmax = fmaxf(rmax, inp(a, 18)[i]);
                    const float negMb = uni(-(64.0f * QSCALE * 1.01f) * wave_max(fabsf(inp(a, 16)[lane])) * wave_max(fabsf(inp(a, 17)[lane])) - wave_max(rmax) * L2E);
                    for (int u = bid; u < 1536 + 3072; u += G) {
                        if (u < 1536) {
#ifndef NO_DIFF
 diff_unit(lds, BIG, XN, (float*)(WSP + WS_STASH) + (size_t)bid * 64 * NTHREADS, inp(a, 15), lam, 1.0f - lambda_init, negMa, u >> 5, (u >> 3) & 3, u & 7, tid, wave, lane);
#endif
 }
                        else { const int v = u - 1536;
#ifndef NO_NA
 na_unit(lds, BIG, XN, inp(a, 18), negMb, v >> 6, (v >> 3) & 7, v & 7, tid, wave, lane);
#endif
 }
                    }
                } else {
                    const float negMc = uni(-(64.0f * QSCALE * 1.01f) * wave_max(fabsf(inp(a, 21)[lane])) * wave_max(fabsf(inp(a, 22)[lane])));
                    for (int u = bid; u < NBATCH * 16 * 4; u += G) {
#ifndef NO_GQA
 gqa_unit64(lds, BIG, XN, negMc, u >> 6, (u >> 2) & 15, u & 3, tid, wave, lane);
#endif
 }
#ifdef PROBE_VAR
                    for (int u = bid; u < NBATCH * 16 * 8; u += G) gqa_unit<PROBE_VAR>(lds, BIG, BIG + (size_t)NTOK * LD1, negMc, u >> 7, (u >> 3) & 15, u & 7, tid, wave, lane);
#endif
                }
            }
        }
        if (ph + 1 < kargs()->hi) { if (ph == kargs()->lo) cg::this_grid().sync(); else xcd_barrier(xbar); }
#ifdef PROBE_SYNC
        if (ph == 14) { for (int i_ = 0; i_ < 40; ++i_) xcd_barrier(xbar); }
#endif
    }
}

#undef G
#undef bid
#undef gw
#undef ngw
#undef X
#undef XN
#undef BIG
#undef SS
#ifndef N_LAUNCH_MODE
#define N_LAUNCH_MODE 0
#endif
extern "C" void kernel_launch(void* const* d_in, const int* in_sizes, int n_in, void* d_out, int out_size, void* d_ws, size_t ws_size, hipStream_t stream) {
    static int grid = 0;
    if (grid == 0) {
        if (n_in != 28 || out_size != NTOK * DM || ws_size < WS_END) { fprintf(stderr, "kernel_launch: unexpected shapes (n_in %d out %d ws %zu)\n", n_in, out_size, ws_size); grid = -1; return; }
        int dev = 0, cus = 0, per_cu = 0;
        if (hipGetDevice(&dev) != hipSuccess || hipDeviceGetAttribute(&cus, hipDeviceAttributeMultiprocessorCount, dev) != hipSuccess) { grid = -1; return; }
        if (hipFuncSetAttribute((const void*)trunk_fwd, hipFuncAttributeMaxDynamicSharedMemorySize, LDS_BYTES) != hipSuccess) { fprintf(stderr, "kernel_launch: hipFuncSetAttribute failed\n"); grid = -1; return; }
        if (hipOccupancyMaxActiveBlocksPerMultiprocessor(&per_cu, (const void*)trunk_fwd, NTHREADS, LDS_BYTES) != hipSuccess || per_cu < 1) { fprintf(stderr, "kernel_launch: occupancy query says %d\n", per_cu); per_cu = 1; }
        (void)hipGetLastError();
        grid = cus * 1;
    }
    if (grid < 0) return;
    if (hipMemsetAsync((char*)d_ws + WS_CTL, 0, CTL_BYTES, stream) != hipSuccess) { fprintf(stderr, "kernel_launch: memset failed\n"); return; }
    Args a{};
    for (int i = 0; i < 28; ++i) a.in[i] = (const float*)d_in[i];
    a.out = (float*)d_out; a.ws = (unsigned char*)d_ws; a.grid = grid; a.ascale = 1;
#if N_LAUNCH_MODE == 1
    for (int ph = 0; ph < NPHASES; ++ph) { a.lo = ph; a.hi = ph + 1; hipLaunchKernelGGL(trunk_fwd, dim3(grid), dim3(NTHREADS), LDS_BYTES, stream, a); }
#elif defined(PROBE_PH)
    const int cuts[4][2] = {{0, PROBE_PH + 1}, {PROBE_PH, PROBE_PH + 1}, {PROBE_PH + 1, NPHASES}, {0, 0}};
    for (int li = 0; li < 3; ++li) { a.lo = cuts[li][0]; a.hi = cuts[li][1]; a.ascale = (li == 1) ? 0 : 1; a.li = li; void* args[] = {&a};
        hipError_t e = hipLaunchCooperativeKernel((const void*)trunk_fwd, dim3(grid), dim3(NTHREADS), args, LDS_BYTES, stream);
        if (e != hipSuccess) fprintf(stderr, "kernel_launch: cooperative launch failed: %s (grid %d)\n", hipGetErrorString(e), grid); }
#else
    a.lo = 0; a.hi = NPHASES;
    void* args[] = {&a};
    hipError_t e = hipLaunchCooperativeKernel((const void*)trunk_fwd, dim3(grid), dim3(NTHREADS), args, LDS_BYTES, stream);
    if (e != hipSuccess) fprintf(stderr, "kernel_launch: cooperative launch failed: %s (grid %d)\n", hipGetErrorString(e), grid);
#endif
}
```
